# Optimizing an MI355X kernel written in HIP

```python
import math, functools
import jax, jax.numpy as jnp
from jax import lax
import numpy as np

D_MODEL = 1024
BATCH = 4
SEQ = 8192
DEPTH = 1

HEAD_DIM = 64
N_HEADS_TOTAL = D_MODEL // HEAD_DIM
N_ATT_HEADS = N_HEADS_TOTAL // 2
N_RWKV_HEADS = N_HEADS_TOTAL - N_ATT_HEADS
ATT_WIDTH = N_ATT_HEADS * HEAD_DIM
RWKV_WIDTH = N_RWKV_HEADS * HEAD_DIM
MIX_WIDTH = ATT_WIDTH + RWKV_WIDTH
ROPE_DIM = HEAD_DIM // 4
ROPE_THETA = 500000.0
DILATED_PATTERNS = ((128, 1), (512, 4), (2048, 16))
SEQ_ALIGN = functools.reduce(math.lcm, [w for w, _ in DILATED_PATTERNS])
DECAY_LORA = 64
AAA_LORA = 64
GATE_LORA = 128
ATT_COLS = 3 * ATT_WIDTH
SHIFT_COLS = 3 * RWKV_WIDTH + DECAY_LORA + AAA_LORA + GATE_LORA
IN_COLS = ATT_COLS + SHIFT_COLS
FFN_HIDDEN = -(-8 * D_MODEL // (3 * 256)) * 256
ALPHA = (2.0 * DEPTH) ** 0.25
BETA = (8.0 * DEPTH) ** -0.25
LN_EPS = 1e-5
GN_EPS = 64e-5
L2_EPS = 1e-6
DECAY_SCALE = math.exp(-0.5)

kernel_name = 'hymba_dilated_attn_rwkv7_deepnorm'


def layer_norm(x, g, b):
    xf = x.astype(jnp.float32)
    mu = jnp.mean(xf, axis=-1, keepdims=True)
    var = jnp.mean(jnp.square(xf - mu), axis=-1, keepdims=True)
    return ((xf - mu) * lax.rsqrt(var + LN_EPS) * g + b).astype(x.dtype)


def partial_rope(t, positions):
    half = ROPE_DIM // 2
    inv_freq = ROPE_THETA ** (-jnp.arange(half, dtype=jnp.float32) / half)
    ang = positions.astype(jnp.float32)[:, None, :, None] * inv_freq
    cos, sin = jnp.cos(ang), jnp.sin(ang)
    tf = t.astype(jnp.float32)
    x1, x2 = tf[..., :half], tf[..., half:ROPE_DIM]
    out = jnp.concatenate([x1 * cos - x2 * sin, x2 * cos + x1 * sin, tf[..., ROPE_DIM:]], axis=-1)
    return out.astype(t.dtype)


def strided_band_attention(q, k, v, window, dilation):
    B, H, Sp, Dh = q.shape
    n_back = window // dilation
    blk = n_back
    Q = Sp // dilation
    nb = Q // blk

    def to_blocks(t):
        t = t.reshape(B, H, Q, dilation, Dh).transpose(0, 1, 3, 2, 4)
        return t.reshape(B, H, dilation, nb, blk, Dh)

    def with_prev(t):
        prev = jnp.pad(t, ((0, 0), (0, 0), (0, 0), (1, 0), (0, 0), (0, 0)))[:, :, :, :-1]
        return jnp.concatenate([prev, t], axis=4)

    qb = to_blocks(q).astype(jnp.float32)
    kc = with_prev(to_blocks(k)).astype(jnp.float32)
    vc = with_prev(to_blocks(v)).astype(jnp.float32)
    s = jnp.einsum('bhrnqd,bhrnkd->bhrnqk', qb, kc) * (Dh ** -0.5)
    qi = jnp.arange(blk)[:, None]
    kj = jnp.arange(2 * blk)[None, :]
    delta = qi + blk - kj
    band = (delta >= 0) & (delta <= n_back)
    not_before_start = (jnp.arange(nb)[:, None, None] > 0) | (kj >= blk)[None]
    valid = band[None] & not_before_start
    s = jnp.where(valid, s, -jnp.inf)
    m = jnp.max(s, axis=-1, keepdims=True)
    p = jnp.exp(s - m)
    l = jnp.sum(p, axis=-1)
    o = jnp.einsum('bhrnqk,bhrnkd->bhrnqd', p, vc) / l[..., None]
    lse = m[..., 0] + jnp.log(l)
    o = o.reshape(B, H, dilation, Q, Dh).transpose(0, 1, 3, 2, 4).reshape(B, H, Sp, Dh)
    lse = lse.reshape(B, H, dilation, Q).transpose(0, 1, 3, 2).reshape(B, H, Sp)
    return o, lse


def dilated_attention(q, k, v):
    S = q.shape[2]
    s_pad = -(-S // SEQ_ALIGN) * SEQ_ALIGN
    pad = ((0, 0), (0, 0), (0, s_pad - S), (0, 0))
    qp, kp, vp = jnp.pad(q, pad), jnp.pad(k, pad), jnp.pad(v, pad)
    outs, lses = [], []
    for window, dilation in DILATED_PATTERNS:
        o, lse = strided_band_attention(qp, kp, vp, window, dilation)
        outs.append(o)
        lses.append(lse)
    wts = jax.nn.softmax(jnp.stack(lses, axis=0), axis=0)
    o = jnp.einsum('pbhs,pbhsd->bhsd', wts, jnp.stack(outs, axis=0))
    return o[:, :, :S]


def token_shift(y):
    return jnp.pad(y, ((0, 0), (1, 0), (0, 0)))[:, :-1]


def rwkv7_recurrence(r, w, k, v, a_vec, b_vec):
    Bsz, _, H, N = r.shape

    def step(state, inp):
        r_t, w_t, k_t, v_t, a_t, b_t = inp
        sa = jnp.einsum('bhvk,bhk->bhv', state, a_t)
        state = (state * w_t[:, :, None, :] + sa[..., None] * b_t[:, :, None, :]
                 + v_t[..., None] * k_t[:, :, None, :])
        return state, jnp.einsum('bhvk,bhk->bhv', state, r_t)

    xs = tuple(jnp.moveaxis(t.astype(jnp.float32), 1, 0) for t in (r, w, k, v, a_vec, b_vec))
    init = jnp.zeros((Bsz, H, N, N), jnp.float32)
    _, o = lax.scan(step, init, xs)
    return jnp.moveaxis(o, 0, 1)


def setup_inputs(seed: int = 0) -> dict:
    key = jax.random.key(seed)
    ks = jax.random.split(key, 24)

    def nrm(k, shape, scale):
        return jax.random.normal(k, shape, jnp.float32) * scale

    x = nrm(ks[0], (BATCH, SEQ, D_MODEL), 1.0)
    offsets = jax.random.randint(ks[1], (BATCH, 1), 0, 4096, dtype=jnp.int32)
    positions = (offsets + jnp.arange(SEQ, dtype=jnp.int32)[None, :]).astype(jnp.int32)
    col_scale = jnp.ones((IN_COLS,), jnp.float32)
    col_scale = col_scale.at[2 * ATT_WIDTH:3 * ATT_WIDTH].set(BETA)
    col_scale = col_scale.at[ATT_COLS + 2 * RWKV_WIDTH:ATT_COLS + 3 * RWKV_WIDTH].set(BETA)
    w_in = nrm(ks[2], (DEPTH, D_MODEL, IN_COLS), D_MODEL ** -0.5) * col_scale
    w_out = nrm(ks[3], (DEPTH, MIX_WIDTH, D_MODEL), MIX_WIDTH ** -0.5 * BETA)
    mu_shift = jax.random.uniform(ks[4], (DEPTH, SHIFT_COLS), jnp.float32, 0.2, 0.8)
    w0 = jax.random.uniform(ks[5], (DEPTH, RWKV_WIDTH), jnp.float32, -3.0, 3.0)
    w_decay_up = nrm(ks[6], (DEPTH, DECAY_LORA, RWKV_WIDTH), 0.5 * DECAY_LORA ** -0.5)
    a0 = nrm(ks[7], (DEPTH, RWKV_WIDTH), 0.1)
    w_aaa_up = nrm(ks[8], (DEPTH, AAA_LORA, RWKV_WIDTH), 0.5 * AAA_LORA ** -0.5)
    w_gate_up = nrm(ks[9], (DEPTH, GATE_LORA, RWKV_WIDTH), GATE_LORA ** -0.5)
    k_k = 0.85 + nrm(ks[10], (DEPTH, RWKV_WIDTH), 0.05)
    k_a = 1.0 + nrm(ks[11], (DEPTH, RWKV_WIDTH), 0.05)
    r_k = nrm(ks[12], (DEPTH, N_RWKV_HEADS, HEAD_DIM), 0.1)
    gn_g = 1.0 + nrm(ks[13], (DEPTH, RWKV_WIDTH), 0.02)
    gn_b = nrm(ks[14], (DEPTH, RWKV_WIDTH), 0.02)
    ln_mix_g = 1.0 + nrm(ks[15], (DEPTH, D_MODEL), 0.02)
    ln_mix_b = nrm(ks[16], (DEPTH, D_MODEL), 0.02)
    w_ffn_gate = nrm(ks[17], (DEPTH, D_MODEL, FFN_HIDDEN), D_MODEL ** -0.5)
    w_ffn_up = nrm(ks[18], (DEPTH, D_MODEL, FFN_HIDDEN), D_MODEL ** -0.5)
    w_ffn_down = nrm(ks[19], (DEPTH, FFN_HIDDEN, D_MODEL), FFN_HIDDEN ** -0.5 * BETA)
    ln_ffn_g = 1.0 + nrm(ks[20], (DEPTH, D_MODEL), 0.02)
    ln_ffn_b = nrm(ks[21], (DEPTH, D_MODEL), 0.02)
    return {'x': x, 'positions': positions, 'w_in': w_in, 'w_out': w_out,
            'mu_shift': mu_shift, 'w0': w0, 'w_decay_up': w_decay_up, 'a0': a0,
            'w_aaa_up': w_aaa_up, 'w_gate_up': w_gate_up, 'k_k': k_k, 'k_a': k_a,
            'r_k': r_k, 'gn_g': gn_g, 'gn_b': gn_b, 'ln_mix_g': ln_mix_g,
            'ln_mix_b': ln_mix_b, 'w_ffn_gate': w_ffn_gate, 'w_ffn_up': w_ffn_up,
            'w_ffn_down': w_ffn_down, 'ln_ffn_g': ln_ffn_g, 'ln_ffn_b': ln_ffn_b}


def reference(x, positions, w_in, w_out, mu_shift, w0, w_decay_up, a0, w_aaa_up,
              w_gate_up, k_k, k_a, r_k, gn_g, gn_b, ln_mix_g, ln_mix_b,
              w_ffn_gate, w_ffn_up, w_ffn_down, ln_ffn_g, ln_ffn_b):
    B, S, _ = x.shape
    rw_split = [RWKV_WIDTH, 2 * RWKV_WIDTH, 3 * RWKV_WIDTH,
                3 * RWKV_WIDTH + DECAY_LORA, 3 * RWKV_WIDTH + DECAY_LORA + AAA_LORA]
    h = x
    for l in range(DEPTH):
        y = jnp.einsum('bsd,dc->bsc', h, w_in[l])
        y_att, y_rw = y[..., :ATT_COLS], y[..., ATT_COLS:]

        q, k, v = jnp.split(y_att, 3, axis=-1)

        def att_heads(t):
            return t.reshape(B, S, N_ATT_HEADS, HEAD_DIM).transpose(0, 2, 1, 3)

        q = partial_rope(att_heads(q), positions)
        k = partial_rope(att_heads(k), positions)
        o_att = dilated_attention(q, k, att_heads(v))
        o_att = o_att.transpose(0, 2, 1, 3).reshape(B, S, ATT_WIDTH).astype(h.dtype)

        y_rw = y_rw + mu_shift[l] * (token_shift(y_rw) - y_rw)
        r, kr, vr, dw, da, dg = jnp.split(y_rw, rw_split, axis=-1)
        w_logit = (w0[l] + jnp.tanh(dw) @ w_decay_up[l]).astype(jnp.float32)
        decay = jnp.exp(-DECAY_SCALE * jax.nn.sigmoid(w_logit))
        a = jax.nn.sigmoid((a0[l] + da @ w_aaa_up[l]).astype(jnp.float32))
        g = jax.nn.sigmoid(dg) @ w_gate_up[l]

        def rw_heads(t):
            return t.reshape(B, S, N_RWKV_HEADS, HEAD_DIM)

        kk = rw_heads((kr * k_k[l]).astype(jnp.float32))
        kk = kk / jnp.maximum(jnp.linalg.norm(kk, axis=-1, keepdims=True), L2_EPS)
        a_h = rw_heads(a)
        k_a_h = k_a[l].reshape(N_RWKV_HEADS, HEAD_DIM).astype(jnp.float32)
        k_mod = rw_heads(kr).astype(jnp.float32) * (1.0 + (a_h - 1.0) * k_a_h)
        r_h = rw_heads(r).astype(jnp.float32)
        v_h = rw_heads(vr).astype(jnp.float32)
        o = rwkv7_recurrence(r_h, rw_heads(decay), k_mod, v_h, -kk, kk * a_h)
        mu = jnp.mean(o, axis=-1, keepdims=True)
        var = jnp.mean(jnp.square(o - mu), axis=-1, keepdims=True)
        o = ((o - mu) * lax.rsqrt(var + GN_EPS)).reshape(B, S, RWKV_WIDTH) * gn_g[l] + gn_b[l]
        bonus = jnp.sum(r_h * k_mod * r_k[l], axis=-1, keepdims=True) * v_h
        o_rw = ((o + bonus.reshape(B, S, RWKV_WIDTH)) * g).astype(h.dtype)

        mix = jnp.concatenate([o_att, o_rw], axis=-1) @ w_out[l]
        h = layer_norm(ALPHA * h + mix, ln_mix_g[l], ln_mix_b[l])

        ffn = (jax.nn.silu(h @ w_ffn_gate[l]) * (h @ w_ffn_up[l])) @ w_ffn_down[l]
        h = layer_norm(ALPHA * h + ffn, ln_ffn_g[l], ln_ffn_b[l])
    return h
```

```cpp
#include <hip/hip_runtime.h>
#include <cstdio>
#include <cstdint>
namespace pg8 {
#define PG8_LAS __attribute__((address_space(3)))
typedef unsigned short bf16_t;
typedef short bf16x8 __attribute__((ext_vector_type(8)));
typedef float f32x4 __attribute__((ext_vector_type(4)));
typedef unsigned u32x4 __attribute__((ext_vector_type(4)));
constexpr int BM = 256, BK = 64, HALF = 128, HTB = HALF * BK * 2  , STAGE_BYTES = 8 * HTB, NXCD = 8, WGM = 8;

__host__ __device__ __forceinline__ int lds_byte(int r, int c) { const int st = (r >> 4) * 2 + (c >> 5), rr = r & 15, cc = c & 31, ob = rr * 64 + cc * 2; return st * 1024 + (ob ^ (((ob >> 9) & 1) << 5)); }
__host__ __device__ __forceinline__ void stage_rc(int b, int& R, int& C) { const int st = b / 1024, sb = b % 1024, swz = sb ^ (((sb >> 9) & 1) << 5); R = (st >> 1) * 16 + swz / 64; C = (st & 1) * 32 + (swz % 64) / 2; }
__host__ __device__ __forceinline__ int perm32(int rho) { const int n = rho >> 4, i = rho & 15; return 8 * (i >> 2) + 4 * n + (i & 3); }

struct Unit { int pm, pn; };
struct Gemm { const bf16_t* A; const bf16_t* Bt; int M, N, K; };

struct StaticOrder {
    int nM, nN, nwg, G, c;
    __host__ __device__ void init(int M, int N, int G_, int c_) { nM = M / BM; nN = N / BM; nwg = nM * nN; G = G_; c = c_; }
    __host__ __device__ bool next(int i, Unit& u) const {
        const long L = (long)i * G + c; if (L >= nwg) return false;
        int wgid = (int)L; { const int q = nwg / NXCD, r = nwg % NXCD, xcd = wgid % NXCD, off = wgid / NXCD; wgid = (xcd < r ? xcd * (q + 1) : r * (q + 1) + (xcd - r) * q) + off; }
        const int nig = WGM * nN, gid = wgid / nig, fm = gid * WGM, gsz = (nM - fm) < WGM ? (nM - fm) : WGM;
        u.pm = fm + ((wgid % nig) % gsz); u.pn = (wgid % nig) / gsz; return true;
    }
    __device__ __forceinline__ void a_ready(const Unit&) const {}
    __device__ __forceinline__ void done(const Unit&) const {}
};


__device__ __forceinline__ unsigned cvt_pk_bf16(float lo, float hi) { unsigned r; asm volatile("v_cvt_pk_bf16_f32 %0, %1, %2" : "=v"(r) : "v"(lo), "v"(hi)); return r; }

struct EpiInProj {
    static constexpr bool PERM = true, AFTER_DRAIN = false;
    bf16_t* Y; const float* cs; int ldc; float qscale;
    __device__ __forceinline__ void operator()(const f32x4 (&acc)[2][2][4][2], const Unit& u, int wr, int wc, int fr, int fq) const {
        const int row0 = u.pm * BM + wr * 64 + fr, col0 = u.pn * BM + wc * 32 + 8 * fq;
        const bool rope = (u.pn < 4) && ((wc & 1) == 0);
        const float qs = (u.pn < 2) ? qscale : 1.f;
        const float sg = (fq == 0) ? -1.f : 1.f;
#pragma unroll
        for (int ai = 0; ai < 2; ++ai)
#pragma unroll
            for (int m = 0; m < 4; ++m) {
                const int row = row0 + ai * HALF + m * 16;
                bf16_t* rowp = Y + (size_t)row * ldc + col0;
                f32x4 c0 = {1.f, 1.f, 1.f, 1.f}, c1 = c0, s0 = {0.f, 0.f, 0.f, 0.f}, s1 = s0;
                if (rope) { const f32x4* cp = (const f32x4*)(cs + (size_t)row * 16); c0 = cp[0]; c1 = cp[1]; s0 = cp[2]; s1 = cp[3]; }
#pragma unroll
                for (int bj = 0; bj < 2; ++bj) {
                    f32x4 v0 = acc[ai][bj][m][0], v1 = acc[ai][bj][m][1];
                    if (rope) {
                        f32x4 o0, o1;
#pragma unroll
                        for (int e = 0; e < 4; ++e) { o0[e] = __shfl_xor(v0[e], 16); o1[e] = __shfl_xor(v1[e], 16); }
                        const f32x4 r0 = v0 * c0 + (o0 * s0) * sg, r1 = v1 * c1 + (o1 * s1) * sg;
                        if (fq < 2) { v0 = r0; v1 = r1; }
                    }
                    v0 = v0 * qs; v1 = v1 * qs;
                    u32x4 w; w.x = cvt_pk_bf16(v0[0], v0[1]); w.y = cvt_pk_bf16(v0[2], v0[3]); w.z = cvt_pk_bf16(v1[0], v1[1]); w.w = cvt_pk_bf16(v1[2], v1[3]);
                    *(u32x4*)(rowp + bj * HALF) = w;
                }
            }
    }
};

struct EpiSwiGLU {
    static constexpr bool PERM = true, AFTER_DRAIN = false;
    bf16_t* H; int ldc;
    __device__ __forceinline__ void operator()(const f32x4 (&acc)[2][2][4][2], const Unit& u, int wr, int wc, int fr, int fq) const {
        const int row0 = u.pm * BM + wr * 64 + fr, col0 = u.pn * HALF + wc * 32 + 8 * fq;
#pragma unroll
        for (int ai = 0; ai < 2; ++ai)
#pragma unroll
            for (int m = 0; m < 4; ++m) {
                bf16_t* rowp = H + (size_t)(row0 + ai * HALF + m * 16) * ldc + col0;
                float h[8];
#pragma unroll
                for (int n = 0; n < 2; ++n)
#pragma unroll
                    for (int e = 0; e < 4; ++e) { const float g = acc[ai][0][m][n][e], up = acc[ai][1][m][n][e];
                        const float sig = __builtin_amdgcn_rcpf(1.f + __builtin_amdgcn_exp2f(-1.4426950408889634f * g)); h[n * 4 + e] = g * sig * up; }
                u32x4 w; w.x = cvt_pk_bf16(h[0], h[1]); w.y = cvt_pk_bf16(h[2], h[3]); w.z = cvt_pk_bf16(h[4], h[5]); w.w = cvt_pk_bf16(h[6], h[7]);
                *(u32x4*)rowp = w;
            }
    }
};

struct EpiResF32 {
    static constexpr bool PERM = false, AFTER_DRAIN = false;
    const float* base; float* out; int ldc; float alpha;
    __device__ __forceinline__ void operator()(const f32x4 (&acc)[2][2][4][2], const Unit& u, int wr, int wc, int fr, int fq) const {
        const int row0 = u.pm * BM + wr * 64 + fr, col0 = u.pn * BM + wc * 32 + 4 * fq;
#pragma unroll
        for (int ai = 0; ai < 2; ++ai)
#pragma unroll
            for (int m = 0; m < 4; ++m) { const size_t off = (size_t)(row0 + ai * HALF + m * 16) * ldc + col0;
#pragma unroll
                for (int bj = 0; bj < 2; ++bj)
#pragma unroll
                    for (int n = 0; n < 2; ++n) { const f32x4 bs = *(const f32x4*)(base + off + bj * HALF + n * 16); *(f32x4*)(out + off + bj * HALF + n * 16) = bs * alpha + acc[ai][bj][m][n]; } }
    }
};

template <class Epi, class Sched, bool ALIGN_EPI = false, bool SP2 = false>
__device__ __forceinline__ void gemm_phase(PG8_LAS unsigned char* lds, const Gemm g, const Sched& S, const Epi& E) {
    const int tid = threadIdx.x, wid = __builtin_amdgcn_readfirstlane(tid >> 6), lane = tid & 63, wr = wid >> 2, wc = wid & 3, fr = lane & 15, fq = lane >> 4;
    const int K = g.K, nt = K / BK;
    unsigned voffA[2], voffB[2];
#pragma unroll
    for (int i = 0; i < 2; ++i) { int R, C; stage_rc(tid * 16 + i * 8192, R, C); const int Rb = Epi::PERM ? ((R & ~31) + perm32(R & 31)) : R;
        voffA[i] = (unsigned)(R * K + C) * 2u; voffB[i] = (unsigned)(Rb * K + C) * 2u; }
    const size_t kstep = (size_t)(BK * 2);
    const size_t hstep = (size_t)HALF * K * 2;
    const size_t tstep = 2 * hstep;
    const unsigned ldsw = (unsigned)wid * 1024u;
    const int aoff = lds_byte(wr * 64 + fr, fq * 8), boff = lds_byte(wc * 32 + fr, fq * 8);
#define PG8_SA(b, h) (((b) * 2 + (h)) * HTB)
#define PG8_SB(b, h) ((4 + (b) * 2 + (h)) * HTB)
#define PG8_STAGE(bufoff, gbase, voff) do { _Pragma("unroll") for (int _i = 0; _i < 2; ++_i) \
        __builtin_amdgcn_global_load_lds((const unsigned*)((const char*)(gbase) + (voff)[_i]), (PG8_LAS unsigned*)(lds + (bufoff) + ldsw + _i * 8192), 16, 0, 0); } while (0)
#define PG8_LDA(dst, b, h) do { _Pragma("unroll") for (int m = 0; m < 4; ++m) _Pragma("unroll") for (int k = 0; k < 2; ++k) dst[m][k] = *(const PG8_LAS bf16x8*)(lds + PG8_SA(b, h) + aoff + m * 2048 + k * 1024); } while (0)
#define PG8_LDB(dst, b, h) do { _Pragma("unroll") for (int n = 0; n < 2; ++n) _Pragma("unroll") for (int k = 0; k < 2; ++k) dst[n][k] = *(const PG8_LAS bf16x8*)(lds + PG8_SB(b, h) + boff + n * 2048 + k * 1024); } while (0)
#define PG8_MMA(ai, bj, At, Bt) do { __builtin_amdgcn_s_setprio(1); _Pragma("unroll") for (int m = 0; m < 4; ++m) _Pragma("unroll") for (int n = 0; n < 2; ++n) _Pragma("unroll") for (int k = 0; k < 2; ++k) \
        acc[ai][bj][m][n] = __builtin_amdgcn_mfma_f32_16x16x32_bf16(Bt[n][k], At[m][k], acc[ai][bj][m][n], 0, 0, 0); __builtin_amdgcn_s_setprio(0); } while (0)
#define PG8_WAIT_V(n) asm volatile("s_waitcnt vmcnt(" #n ")" ::: "memory")
#define PG8_WAIT_L(n) asm volatile("s_waitcnt lgkmcnt(" #n ")" ::: "memory")
#define PG8_BAR __builtin_amdgcn_s_barrier()
#define PG8_SCHED __builtin_amdgcn_sched_barrier(0)
    Unit cur, nxt; int ui = 0;
    if (!S.next(0, cur)) return;
    f32x4 acc[2][2][4][2];
#pragma unroll
    for (int a = 0; a < 2; ++a)
#pragma unroll
        for (int b = 0; b < 2; ++b)
#pragma unroll
            for (int m = 0; m < 4; ++m)
#pragma unroll
                for (int n = 0; n < 2; ++n) acc[a][b][m][n] = (f32x4){0.f, 0.f, 0.f, 0.f};
    bf16x8 At[4][2], B0[2][2], B1[2][2];
    const char* cA = (const char*)g.A + (size_t)cur.pm * tstep; const char* cB = (const char*)g.Bt + (size_t)cur.pn * tstep;
    S.a_ready(cur);
    if constexpr (SP2) {
        PG8_STAGE(PG8_SB(0, 0), cB, voffB); PG8_STAGE(PG8_SB(0, 1), cB + hstep, voffB); PG8_STAGE(PG8_SA(0, 0), cA, voffA); PG8_STAGE(PG8_SA(0, 1), cA + hstep, voffA);
        if (wr == 1) PG8_BAR;
        PG8_WAIT_V(2); PG8_BAR;
        PG8_STAGE(PG8_SB(1, 0), cB + kstep, voffB); PG8_STAGE(PG8_SA(1, 0), cA + kstep, voffA); PG8_STAGE(PG8_SB(1, 1), cB + hstep + kstep, voffB);
        PG8_WAIT_V(6); PG8_BAR;
    } else {
        PG8_STAGE(PG8_SB(0, 0), cB, voffB); PG8_STAGE(PG8_SA(0, 0), cA, voffA); PG8_STAGE(PG8_SB(0, 1), cB + hstep, voffB); PG8_STAGE(PG8_SA(0, 1), cA + hstep, voffA);
        if (wr == 1) PG8_BAR;
        PG8_WAIT_V(4); PG8_BAR;
        PG8_STAGE(PG8_SB(1, 0), cB + kstep, voffB); PG8_STAGE(PG8_SA(1, 0), cA + kstep, voffA); PG8_STAGE(PG8_SB(1, 1), cB + hstep + kstep, voffB);
        PG8_WAIT_V(6); PG8_BAR;
    }
    for (;;) {
        const bool has_next = S.next(ui + 1, nxt);
        const char* nA = has_next ? (const char*)g.A + (size_t)nxt.pm * tstep : cA; const char* nB = has_next ? (const char*)g.Bt + (size_t)nxt.pn * tstep : cB;
        for (int t = 0; t < nt; t += 2) {
            const bool last = (t == nt - 2);
            const char* a1 = cA + (size_t)(t + 1) * kstep;
            const char* a2 = last ? nA : cA + (size_t)(t + 2) * kstep; const char* b2 = last ? nB : cB + (size_t)(t + 2) * kstep;
            const char* a3 = a2 + kstep; const char* b3 = b2 + kstep;
            if (last && has_next) S.a_ready(nxt);
            if constexpr (SP2) {
            PG8_LDB(B0, 0, 0); PG8_LDB(B1, 0, 1); PG8_SCHED; PG8_LDA(At, 0, 0); PG8_STAGE(PG8_SA(1, 1), a1 + hstep, voffA);
            PG8_WAIT_V(8); PG8_WAIT_L(0); PG8_BAR; PG8_MMA(0, 0, At, B0); PG8_MMA(0, 1, At, B1); PG8_BAR; PG8_SCHED;
            PG8_LDA(At, 0, 1); PG8_STAGE(PG8_SB(0, 0), b2, voffB); PG8_STAGE(PG8_SB(0, 1), b2 + hstep, voffB); PG8_STAGE(PG8_SA(0, 0), a2, voffA);
            PG8_WAIT_V(8); PG8_WAIT_L(0); PG8_BAR; PG8_MMA(1, 0, At, B0); PG8_MMA(1, 1, At, B1); PG8_BAR; PG8_SCHED;
            PG8_LDB(B0, 1, 0); PG8_LDB(B1, 1, 1); PG8_SCHED; PG8_LDA(At, 1, 0); PG8_STAGE(PG8_SA(0, 1), a2 + hstep, voffA);
            PG8_WAIT_V(8); PG8_WAIT_L(0); PG8_BAR; PG8_MMA(0, 0, At, B0); PG8_MMA(0, 1, At, B1); PG8_BAR; PG8_SCHED;
            PG8_LDA(At, 1, 1); PG8_STAGE(PG8_SB(1, 0), b3, voffB); PG8_STAGE(PG8_SB(1, 1), b3 + hstep, voffB); PG8_STAGE(PG8_SA(1, 0), a3, voffA);
            PG8_WAIT_V(8); PG8_WAIT_L(0); PG8_BAR; PG8_MMA(1, 0, At, B0); PG8_MMA(1, 1, At, B1); PG8_BAR; PG8_SCHED;
            } else {
            PG8_LDB(B0, 0, 0); PG8_SCHED; PG8_LDA(At, 0, 0); PG8_STAGE(PG8_SA(1, 1), a1 + hstep, voffA);
            PG8_WAIT_L(8); PG8_BAR; PG8_WAIT_L(0); PG8_MMA(0, 0, At, B0); PG8_BAR; PG8_SCHED;
            PG8_LDB(B1, 0, 1); PG8_STAGE(PG8_SB(0, 0), b2, voffB);
            PG8_BAR; PG8_WAIT_L(0); PG8_MMA(0, 1, At, B1); PG8_BAR;
            PG8_LDA(At, 0, 1); PG8_STAGE(PG8_SA(0, 0), a2, voffA);
            PG8_BAR; PG8_WAIT_L(0); PG8_MMA(1, 0, At, B0); PG8_BAR; PG8_SCHED;
            PG8_STAGE(PG8_SB(0, 1), b2 + hstep, voffB);
            PG8_WAIT_V(6); PG8_BAR; PG8_MMA(1, 1, At, B1); PG8_BAR;
            PG8_LDB(B0, 1, 0); PG8_SCHED; PG8_LDA(At, 1, 0); PG8_STAGE(PG8_SA(0, 1), a2 + hstep, voffA);
            PG8_WAIT_L(8); PG8_BAR; PG8_WAIT_L(0); PG8_MMA(0, 0, At, B0); PG8_BAR; PG8_SCHED;
            PG8_LDB(B1, 1, 1); PG8_STAGE(PG8_SB(1, 0), b3, voffB);
            PG8_BAR; PG8_WAIT_L(0); PG8_MMA(0, 1, At, B1); PG8_BAR;
            PG8_LDA(At, 1, 1); PG8_STAGE(PG8_SA(1, 0), a3, voffA);
            PG8_BAR; PG8_WAIT_L(0); PG8_MMA(1, 0, At, B0); PG8_BAR; PG8_SCHED;
            PG8_STAGE(PG8_SB(1, 1), b3 + hstep, voffB);
            PG8_WAIT_V(6); PG8_BAR; PG8_MMA(1, 1, At, B1); PG8_BAR;
            }
        }
        if constexpr (ALIGN_EPI) { if (wr == 0) PG8_BAR; }
        if constexpr (!Epi::AFTER_DRAIN) { E(acc, cur, wr, wc, fr, fq); S.done(cur); }
        if (!has_next) break;
#pragma unroll
        for (int a = 0; a < 2; ++a)
#pragma unroll
            for (int b = 0; b < 2; ++b)
#pragma unroll
                for (int m = 0; m < 4; ++m)
#pragma unroll
                    for (int n = 0; n < 2; ++n) acc[a][b][m][n] = (f32x4){0.f, 0.f, 0.f, 0.f};
        cur = nxt; cA = nA; cB = nB; ++ui;
        if constexpr (ALIGN_EPI) { if (wr == 1) PG8_BAR; }
    }
    PG8_WAIT_V(0);
    if constexpr (!ALIGN_EPI) { if (wr == 0) PG8_BAR; }
    PG8_BAR;
    if constexpr (Epi::AFTER_DRAIN) { E.fused(acc, cur, wr, wc, fr, fq, lds, wid, lane); S.done(cur); }
#undef PG8_SA
#undef PG8_SB
#undef PG8_STAGE
#undef PG8_LDA
#undef PG8_LDB
#undef PG8_MMA
#undef PG8_WAIT_V
#undef PG8_WAIT_L
#undef PG8_BAR
#undef PG8_SCHED
}
}

#define LAS __attribute__((address_space(3)))
typedef unsigned short bf16_t;
typedef short bf16x8 __attribute__((ext_vector_type(8)));
typedef short s16x4 __attribute__((ext_vector_type(4)));
typedef float f32x4 __attribute__((ext_vector_type(4)));
typedef float f32x16 __attribute__((ext_vector_type(16)));
typedef unsigned u32x2 __attribute__((ext_vector_type(2)));
typedef unsigned u32x4 __attribute__((ext_vector_type(4)));

constexpr int NB = 4, SEQ = 8192, DM = 1024, M = NB * SEQ, INC = 3328, FF = 2816, NH = 8, HD = 64;
constexpr int C_Q = 0, C_K = 512, C_V = 1024, C_RW = 1536, C_R = 1536, C_KR = 2048, C_VR = 2560, C_DW = 3072, C_DA = 3136, C_DG = 3200;
constexpr float ALPHA = 1.189207115002721f;
constexpr float LN_EPS = 1e-5f, GN_EPS = 64e-5f, L2_EPS = 1e-6f;
constexpr float DECAY_SCALE = 0.6065306597126334f;
constexpr float LOG2E = 1.4426950408889634f;
constexpr float QSCALE = 0.125f * LOG2E;
constexpr int NWAVES = 8, NTHREADS = 512;

constexpr size_t MiB = 1u << 20;
constexpr size_t WS_CTL = 0, CTL_ZERO_BYTES = 1 * MiB;
constexpr size_t WS_WIN = 1 * MiB, WS_WOUT = 8 * MiB, WS_WGU = 10 * MiB, WS_WDN = 21 * MiB, WS_CS = 28 * MiB;
constexpr size_t WS_Y = 32 * MiB;
constexpr size_t WS_HID = 32 * MiB;
constexpr size_t WS_TMP5 = 32 * MiB;
constexpr size_t WS_XB = 240 * MiB;
constexpr size_t WS_ATTP = 240 * MiB;
constexpr size_t WS_TMP7 = 240 * MiB;
constexpr size_t WS_LSE = 336 * MiB;
constexpr size_t WS_MIX = 340 * MiB;
constexpr size_t WS_H1B = 404 * MiB;
constexpr size_t WS_END = 468 * MiB;

constexpr int LDS_BYTES = 147456;

__device__ __forceinline__ unsigned f2bf(float f) { unsigned u = __builtin_bit_cast(unsigned, f); return (u + 0x7fffu + ((u >> 16) & 1u)) >> 16; }
__device__ __forceinline__ unsigned pk2(float lo, float hi) { return f2bf(lo) | (f2bf(hi) << 16); }
__device__ __forceinline__ float bf2f(unsigned b) { return __builtin_bit_cast(float, b << 16); }
__device__ __forceinline__ float sigmoidf_(float x) { return 1.f / (1.f + __expf(-x)); }
#define LDS_WAIT() asm volatile("s_waitcnt lgkmcnt(0)" ::: "memory")

struct Args {
    const float* in[22]; const int* pos; float* out; unsigned char* ws; int ph_lo, ph_hi, pad0, pad1;
};
enum { I_X = 0, I_POS = 1, I_WIN = 2, I_WOUT = 3, I_MU = 4, I_W0 = 5, I_WD = 6, I_A0 = 7, I_WA = 8, I_WG = 9, I_KK = 10, I_KA = 11, I_RK = 12, I_GNG = 13, I_GNB = 14,
       I_LN1G = 15, I_LN1B = 16, I_FG = 17, I_FU = 18, I_FD = 19, I_LN2G = 20, I_LN2B = 21 };

__device__ __forceinline__ void p0_transpose_item(const float* W, int K, int N, bf16_t* WT, int dst_row0, LAS float* scr, int k0, int n0, int lane) {
#pragma unroll 8
    for (int i = 0; i < 32; ++i) { const int kk = 2 * i + (lane >> 5); scr[kk * 33 + (lane & 31)] = W[(size_t)(k0 + kk) * N + n0 + (lane & 31)]; }
    LDS_WAIT();
    const int c = lane & 7;
#pragma unroll
    for (int j = 0; j < 4; ++j) { const int n = (lane >> 3) + 8 * j; const LAS float* s = scr + (8 * c) * 33 + n;
        u32x4 o; o.x = pk2(s[0 * 33], s[1 * 33]); o.y = pk2(s[2 * 33], s[3 * 33]); o.z = pk2(s[4 * 33], s[5 * 33]); o.w = pk2(s[6 * 33], s[7 * 33]);
        *(u32x4*)(WT + (size_t)(dst_row0 + n) * K + k0 + 8 * c) = o; }
    LDS_WAIT();
}

__device__ __forceinline__ void sincos_rev(float angf, float& c, float& s) {
    const double a = (double)angf;
    double r = a * 0.15915494309189535; r = r - floor(r); if (r >= 0.5) r -= 1.0;
    const double x = r * 6.283185307179586, x2 = x * x;
    double sc = 1.0, ss = 1.0;
    sc = 1.0; ss = 1.0;
#pragma unroll
    for (int k = 13; k >= 1; --k) { sc = 1.0 - sc * x2 * (1.0 / (double)((2 * k - 1) * (2 * k))); ss = 1.0 - ss * x2 * (1.0 / (double)((2 * k) * (2 * k + 1))); }
    c = (float)sc; s = (float)(ss * x);
}

__device__ __forceinline__ void p0_prologue(const Args& A, LAS unsigned char* lds, int vcu, int G, int tid) {
    const int lane = tid & 63, wave = tid >> 6;
    unsigned char* ws = A.ws;
    LAS float* scr = (LAS float*)(lds + wave * 16384);
    const int gw = vcu * NWAVES + wave, NGW = G * NWAVES;
    constexpr int I_IN = (DM / 64) * (INC / 32), I_OUT = (DM / 64) * (DM / 32), I_G = (DM / 64) * (FF / 32), I_D = (FF / 64) * (DM / 32);
    constexpr int NITEMS = I_IN + I_OUT + 2 * I_G + I_D;
    for (int it = gw; it < NITEMS; it += NGW) {
        int r = it;
        if (r < I_IN) { const int nb = INC / 32, kb = r / nb, n0 = 32 * (r % nb); p0_transpose_item(A.in[I_WIN], DM, INC, (bf16_t*)(ws + WS_WIN), n0, scr, 64 * kb, n0, lane); continue; } r -= I_IN;
        if (r < I_OUT) { const int nb = DM / 32, kb = r / nb, n0 = 32 * (r % nb); p0_transpose_item(A.in[I_WOUT], DM, DM, (bf16_t*)(ws + WS_WOUT), n0, scr, 64 * kb, n0, lane); continue; } r -= I_OUT;
        if (r < 2 * I_G) { const int up = r >= I_G; if (up) r -= I_G; const int nb = FF / 32, kb = r / nb, n0 = 32 * (r % nb);
            p0_transpose_item(A.in[up ? I_FU : I_FG], DM, FF, (bf16_t*)(ws + WS_WGU), 256 * (n0 / 128) + (n0 % 128) + (up ? 128 : 0), scr, 64 * kb, n0, lane); continue; } r -= 2 * I_G;
        { const int nb = DM / 32, kb = r / nb, n0 = 32 * (r % nb); p0_transpose_item(A.in[I_FD], FF, DM, (bf16_t*)(ws + WS_WDN), n0, scr, 64 * kb, n0, lane); }
    }
    { const float* x = A.in[I_X]; bf16_t* xb = (bf16_t*)(ws + WS_XB);
      const size_t n8 = (size_t)M * DM / 8;
      for (size_t i = (size_t)vcu * NTHREADS + tid; i < n8; i += (size_t)G * NTHREADS) {
          const f32x4 a = *(const f32x4*)(x + i * 8), b = *(const f32x4*)(x + i * 8 + 4);
          u32x4 o; o.x = pk2(a[0], a[1]); o.y = pk2(a[2], a[3]); o.z = pk2(b[0], b[1]); o.w = pk2(b[2], b[3]);
          *(u32x4*)(xb + i * 8) = o; } }
    { float* cs = (float*)(ws + WS_CS);
      for (int i = vcu * NTHREADS + tid; i < M * 8; i += G * NTHREADS) {
          const int m = i >> 3, f = i & 7;
          const float invf[8] = {1.0f, 0.1939227432012558f, 0.03760603070259094f, 0.007292664609849453f, 0.0014142135623842478f, 0.00027424818836152554f, 5.318296098266728e-05f, 1.0313386155758053e-05f};
          float fr = invf[0];
#pragma unroll
          for (int q = 1; q < 8; ++q) fr = (f == q) ? invf[q] : fr;
          const float ang = (float)A.pos[m] * fr;
          float c, s; sincos_rev(ang, c, s);
          cs[(size_t)m * 16 + f] = c; cs[(size_t)m * 16 + 8 + f] = s; } }
}

__device__ __forceinline__ int crow(int r, int hi) { return (r & 3) + 8 * (r >> 2) + 4 * hi; }
typedef short v4i16_t __attribute__((ext_vector_type(4)));
__device__ __forceinline__ s16x4 vtr(const LAS unsigned char* p) { return __builtin_bit_cast(s16x4, __builtin_amdgcn_ds_read_tr16_b64_v4i16((LAS v4i16_t*)p)); }

constexpr int ATT_KROWS = 384;
constexpr int ATT_LK = 0, ATT_LV = ATT_KROWS * 128, ATT_LW = 2 * ATT_KROWS * 128, ATT_WSCR = 4096 + 256;

__device__ __forceinline__ void attn_partial_phase(LAS unsigned char* lds, const bf16_t* Y, bf16_t* OP, float* LSE, int vcu, int G, int tid) {
    const int lane = tid & 63, wid = __builtin_amdgcn_readfirstlane(tid >> 6), r32 = lane & 31, hi = lane >> 5;
    LAS unsigned char* Kimg = lds + ATT_LK; LAS unsigned char* Vimg = lds + ATT_LV;
    LAS unsigned char* wscr = lds + ATT_LW + wid * ATT_WSCR;
    LAS float* wsf = (LAS float*)(wscr + 4096);
    for (int unit = vcu; unit < 32 * 96; unit += G) {
        const int bh = unit / 96, rem = unit % 96, p = rem >> 5, j = rem & 31;
        const int b = bh >> 3, h = bh & 7;
        const int dl = 2 * p, d = 1 << dl;
        const int nblk = 32 >> dl;
        const int rcls = j / nblk, i0 = (j % nblk) * 256;
        const size_t rowb = (size_t)b * SEQ;
        for (int idx = tid; idx < ATT_KROWS * 8; idx += NTHREADS) {
            const int row = idx >> 3, ch = idx & 7, ci = i0 - 128 + row;
            u32x4 kv = {0u, 0u, 0u, 0u}, vv = kv;
            if (ci >= 0) { const bf16_t* pp = Y + (rowb + (size_t)ci * d + rcls) * INC + h * HD + ch * 8; kv = *(const u32x4*)(pp + C_K); vv = *(const u32x4*)(pp + C_V); }
            *(LAS u32x4*)(Kimg + row * 128 + ((ch ^ ((row >> 1) & 7)) << 4)) = kv;
            *(LAS u32x4*)(Vimg + row * 128 + ((ch ^ (((row >> 1) & 1) << 2)) << 4)) = vv;
        }
        __syncthreads();
        const int qidx = i0 + 32 * wid + r32;
        const bf16_t* qptr = Y + (rowb + (size_t)qidx * d + rcls) * INC + C_Q + h * HD;
        bf16x8 qf[4];
#pragma unroll
        for (int d0 = 0; d0 < 4; ++d0) qf[d0] = *(const bf16x8*)(qptr + 16 * d0 + 8 * hi);
        f32x16 pt[5];
#pragma unroll
        for (int kt = 0; kt < 5; ++kt) {
            f32x16 acc = {};
            const int row = 32 * wid + 32 * kt + r32;
#pragma unroll
            for (int d0 = 0; d0 < 4; ++d0) {
                const int ch = 2 * d0 + hi;
                const bf16x8 kf = *(const LAS bf16x8*)(Kimg + row * 128 + ((ch ^ ((row >> 1) & 7)) << 4));
                acc = __builtin_amdgcn_mfma_f32_32x32x16_bf16(kf, qf[d0], acc, 0, 0, 0);
            }
            pt[kt] = acc;
        }
        float mx = -INFINITY;
#pragma unroll
        for (int kt = 0; kt < 5; ++kt)
#pragma unroll
            for (int r = 0; r < 16; ++r) {
                const int cr = crow(r, hi);
                const int delta = 128 - 32 * kt + r32 - cr;
                const int kidx = i0 - 128 + 32 * wid + 32 * kt + cr;
                const bool valid = (delta >= 0) && (delta <= 128) && (kidx >= 0);
                float v = pt[kt][r]; v = valid ? v : -INFINITY; pt[kt][r] = v; mx = fmaxf(mx, v);
            }
        mx = fmaxf(mx, __shfl_xor(mx, 32));
        float l = 0.f;
#pragma unroll
        for (int kt = 0; kt < 5; ++kt)
#pragma unroll
            for (int r = 0; r < 16; ++r) { const float e = __builtin_amdgcn_exp2f(pt[kt][r] - mx); pt[kt][r] = e; l += e; }
        l += __shfl_xor(l, 32);
        f32x16 o[2]; o[0] = f32x16{}; o[1] = f32x16{};
        const int g1 = (lane >> 4) & 1, q4 = (lane & 15) >> 2, p4 = lane & 3;
#pragma unroll
        for (int kt = 0; kt < 5; ++kt)
#pragma unroll
            for (int s = 0; s < 2; ++s) {
                u32x4 pw;
                pw.x = pk2(pt[kt][8 * s + 0], pt[kt][8 * s + 1]); pw.y = pk2(pt[kt][8 * s + 2], pt[kt][8 * s + 3]);
                pw.z = pk2(pt[kt][8 * s + 4], pt[kt][8 * s + 5]); pw.w = pk2(pt[kt][8 * s + 6], pt[kt][8 * s + 7]);
                const bf16x8 pa = __builtin_bit_cast(bf16x8, pw);
                const int rlo = 32 * wid + 32 * kt + 16 * s + 4 * hi + q4, rhi = rlo + 8;
#pragma unroll
                for (int dh = 0; dh < 2; ++dh) {
                    const int chunk = 4 * dh + 2 * g1 + (p4 >> 1), sub = 8 * (p4 & 1);
                    const s16x4 vlo = vtr(Vimg + rlo * 128 + ((chunk ^ (((rlo >> 1) & 1) << 2)) << 4) + sub);
                    const s16x4 vhi = vtr(Vimg + rhi * 128 + ((chunk ^ (((rhi >> 1) & 1) << 2)) << 4) + sub);
                    const bf16x8 vf = (bf16x8){vlo[0], vlo[1], vlo[2], vlo[3], vhi[0], vhi[1], vhi[2], vhi[3]};
                    o[dh] = __builtin_amdgcn_mfma_f32_32x32x16_bf16(pa, vf, o[dh], 0, 0, 0);
                }
            }
        if (hi == 0) wsf[r32] = l;
        LDS_WAIT();
        bf16_t LAS* stg = (bf16_t LAS*)wscr;
#pragma unroll
        for (int r = 0; r < 16; ++r) {
            const int q = crow(r, hi); const float rl = 1.f / wsf[q];
            stg[q * 64 + r32] = (bf16_t)f2bf(o[0][r] * rl); stg[q * 64 + 32 + r32] = (bf16_t)f2bf(o[1][r] * rl);
        }
        LDS_WAIT();
        bf16_t* OPp = OP + (size_t)p * M * 512;
#pragma unroll
        for (int i = 0; i < 4; ++i) {
            const int q = i * 8 + (lane >> 3), ch = lane & 7;
            const u32x4 v = *(const LAS u32x4*)(wscr + q * 128 + ch * 16);
            const size_t tok = rowb + (size_t)(i0 + 32 * wid + q) * d + rcls;
            *(u32x4*)(OPp + tok * 512 + h * HD + ch * 8) = v;
        }
        if (hi == 0) { const size_t tok = rowb + (size_t)qidx * d + rcls; LSE[(size_t)p * M * 8 + tok * 8 + h] = mx + __log2f(l); }
        __syncthreads();
    }
}

__device__ __forceinline__ void attn_merge_phase(const bf16_t* OP, const float* LSE, bf16_t* MIX, int vcu, int G, int tid) {
    const size_t total = (size_t)M * 64;
    for (size_t i = (size_t)vcu * NTHREADS + tid; i < total; i += (size_t)G * NTHREADS) {
        const size_t tok = i >> 6; const int hc = (int)(i & 63), h = hc >> 3;
        const float l0 = LSE[tok * 8 + h], l1 = LSE[(size_t)M * 8 + tok * 8 + h], l2 = LSE[(size_t)2 * M * 8 + tok * 8 + h];
        const float mx = fmaxf(l0, fmaxf(l1, l2));
        float w0 = __builtin_amdgcn_exp2f(l0 - mx), w1 = __builtin_amdgcn_exp2f(l1 - mx), w2 = __builtin_amdgcn_exp2f(l2 - mx);
        const float inv = 1.f / (w0 + w1 + w2); w0 *= inv; w1 *= inv; w2 *= inv;
        const u32x4 a = *(const u32x4*)(OP + tok * 512 + hc * 8), bq = *(const u32x4*)(OP + (size_t)M * 512 + tok * 512 + hc * 8), c = *(const u32x4*)(OP + (size_t)2 * M * 512 + tok * 512 + hc * 8);
        u32x4 o;
#pragma unroll
        for (int e = 0; e < 4; ++e) {
            const float lo = w0 * bf2f(a[e] & 0xffffu) + w1 * bf2f(bq[e] & 0xffffu) + w2 * bf2f(c[e] & 0xffffu);
            const float hi = w0 * bf2f(a[e] >> 16) + w1 * bf2f(bq[e] >> 16) + w2 * bf2f(c[e] >> 16);
            o[e] = pk2(lo, hi);
        }
        *(u32x4*)(MIX + tok * DM + hc * 8) = o;
    }
}

__device__ __forceinline__ float ysh(const bf16_t* Y, size_t row, int t, int col, const float* mu) {
    const float yc = bf2f(Y[row * INC + col]); const float yp = (t > 0) ? bf2f(Y[(row - 1) * INC + col]) : 0.f;
    return yc + mu[col - C_RW] * (yp - yc);
}
__device__ __forceinline__ void rwkv_direct_phase(LAS unsigned char* lds, const Args& A, const bf16_t* Y, bf16_t* MIX, int vcu, int tid) {
    if (vcu >= 32) return;
    const int b = vcu >> 3, h = vcu & 7;
    LAS float* LIN = (LAS float*)lds;
    LAS float* RR = LIN + 32 * 256;
    LAS float* WW = RR + 2048; LAS float* KM = WW + 2048; LAS float* VV = KM + 2048; LAS float* AV = VV + 2048; LAS float* BV = AV + 2048; LAS float* GG = BV + 2048; LAS float* OB = GG + 2048;
    LAS float* BON = OB + 2048;
    const float* mu = A.in[I_MU];
    float s[8];
#pragma unroll
    for (int i = 0; i < 8; ++i) s[i] = 0.f;
#pragma unroll 1
    for (int ci = 0; ci < SEQ / 32; ++ci) {
        const int t0 = ci * 32; const size_t row0 = (size_t)b * SEQ + t0;
        for (int idx = tid; idx < 32 * 256; idx += NTHREADS) {
            const int tok = idx >> 8, c = idx & 255;
            float v = ysh(Y, row0 + tok, t0 + tok, C_DW + c, mu);
            if (c < 64) v = tanhf(v); else if (c >= 128) v = sigmoidf_(v);
            LIN[idx] = v;
        }
        __syncthreads();
        {
            const int tok = tid >> 4, jg = tid & 15, j0 = 4 * jg, cj = h * 64 + j0;
            float wl[4], al[4], gl[4];
#pragma unroll
            for (int e = 0; e < 4; ++e) { wl[e] = A.in[I_W0][cj + e]; al[e] = A.in[I_A0][cj + e]; gl[e] = 0.f; }
            const LAS float* li = LIN + tok * 256;
#pragma unroll 2
            for (int i = 0; i < 64; ++i) {
                const f32x4 wd = *(const f32x4*)(A.in[I_WD] + (size_t)i * 512 + cj), wa = *(const f32x4*)(A.in[I_WA] + (size_t)i * 512 + cj);
                const float x1 = li[i], x2 = li[64 + i];
#pragma unroll
                for (int e = 0; e < 4; ++e) { wl[e] += x1 * wd[e]; al[e] += x2 * wa[e]; }
            }
#pragma unroll 2
            for (int i = 0; i < 128; ++i) {
                const f32x4 wg = *(const f32x4*)(A.in[I_WG] + (size_t)i * 512 + cj); const float x3 = li[128 + i];
#pragma unroll
                for (int e = 0; e < 4; ++e) gl[e] += x3 * wg[e];
            }
            float r[4], kr[4], vr[4], kk[4]; float n2 = 0.f;
#pragma unroll
            for (int e = 0; e < 4; ++e) {
                r[e] = ysh(Y, row0 + tok, t0 + tok, C_R + cj + e, mu); kr[e] = ysh(Y, row0 + tok, t0 + tok, C_KR + cj + e, mu); vr[e] = ysh(Y, row0 + tok, t0 + tok, C_VR + cj + e, mu);
                kk[e] = kr[e] * A.in[I_KK][cj + e]; n2 += kk[e] * kk[e];
            }
            n2 += __shfl_xor(n2, 1); n2 += __shfl_xor(n2, 2); n2 += __shfl_xor(n2, 4); n2 += __shfl_xor(n2, 8);
            const float inv = 1.f / fmaxf(sqrtf(n2), L2_EPS);
            float bon = 0.f;
#pragma unroll
            for (int e = 0; e < 4; ++e) {
                const float a = sigmoidf_(al[e]); const float dec = __expf(-DECAY_SCALE * sigmoidf_(wl[e]));
                const float kn = kk[e] * inv; const float km = kr[e] * (1.f + (a - 1.f) * A.in[I_KA][cj + e]);
                bon += r[e] * km * A.in[I_RK][cj + e];
                const int o = tok * 64 + j0 + e;
                RR[o] = r[e]; WW[o] = dec; KM[o] = km; VV[o] = vr[e]; AV[o] = -kn; BV[o] = kn * a; GG[o] = gl[e];
            }
            bon += __shfl_xor(bon, 1); bon += __shfl_xor(bon, 2); bon += __shfl_xor(bon, 4); bon += __shfl_xor(bon, 8);
            if (jg == 0) BON[tok] = bon;
        }
        __syncthreads();
        {
            const int v = tid >> 3, kq = tid & 7;
#pragma unroll 1
            for (int t = 0; t < 32; ++t) {
                const int o = t * 64 + 8 * kq;
                const f32x4 a0 = *(const LAS f32x4*)(AV + o), a1 = *(const LAS f32x4*)(AV + o + 4), w0 = *(const LAS f32x4*)(WW + o), w1 = *(const LAS f32x4*)(WW + o + 4);
                const f32x4 b0 = *(const LAS f32x4*)(BV + o), b1 = *(const LAS f32x4*)(BV + o + 4), k0 = *(const LAS f32x4*)(KM + o), k1 = *(const LAS f32x4*)(KM + o + 4);
                const f32x4 r0 = *(const LAS f32x4*)(RR + o), r1 = *(const LAS f32x4*)(RR + o + 4);
                const float vv = VV[t * 64 + v];
                float sa = 0.f;
#pragma unroll
                for (int e = 0; e < 4; ++e) sa += s[e] * a0[e] + s[4 + e] * a1[e];
                sa += __shfl_xor(sa, 1); sa += __shfl_xor(sa, 2); sa += __shfl_xor(sa, 4);
                float oo = 0.f;
#pragma unroll
                for (int e = 0; e < 4; ++e) {
                    s[e] = s[e] * w0[e] + sa * b0[e] + vv * k0[e]; s[4 + e] = s[4 + e] * w1[e] + sa * b1[e] + vv * k1[e];
                    oo += s[e] * r0[e] + s[4 + e] * r1[e];
                }
                oo += __shfl_xor(oo, 1); oo += __shfl_xor(oo, 2); oo += __shfl_xor(oo, 4);
                if (kq == 0) OB[t * 64 + v] = oo;
            }
        }
        __syncthreads();
        {
            const int tok = tid >> 4, jg = tid & 15, v0 = 4 * jg;
            float ov[4], sm = 0.f;
#pragma unroll
            for (int e = 0; e < 4; ++e) { ov[e] = OB[tok * 64 + v0 + e]; sm += ov[e]; }
            sm += __shfl_xor(sm, 1); sm += __shfl_xor(sm, 2); sm += __shfl_xor(sm, 4); sm += __shfl_xor(sm, 8);
            const float mean = sm * (1.f / 64.f); float q = 0.f;
#pragma unroll
            for (int e = 0; e < 4; ++e) { const float dlt = ov[e] - mean; q += dlt * dlt; }
            q += __shfl_xor(q, 1); q += __shfl_xor(q, 2); q += __shfl_xor(q, 4); q += __shfl_xor(q, 8);
            const float rstd = 1.f / sqrtf(q * (1.f / 64.f) + GN_EPS);
            const float bon = BON[tok];
            float res[4];
#pragma unroll
            for (int e = 0; e < 4; ++e) { const int cj = h * 64 + v0 + e;
                const float on = (ov[e] - mean) * rstd * A.in[I_GNG][cj] + A.in[I_GNB][cj];
                res[e] = (on + bon * VV[tok * 64 + v0 + e]) * GG[tok * 64 + v0 + e]; }
            u32x2 w; w.x = pk2(res[0], res[1]); w.y = pk2(res[2], res[3]);
            *(u32x2*)(MIX + (row0 + tok) * DM + 512 + h * 64 + v0) = w;
        }
    }
}

__device__ __forceinline__ float wave_sum(float v) {
#pragma unroll
    for (int o = 1; o < 64; o <<= 1) v += __shfl_xor(v, o);
    return v;
}
__device__ __forceinline__ void ln_rows_phase(const float* in, const float* g, const float* bta, float* outf, bf16_t* outb, int vcu, int G, int tid) {
    const int lane = tid & 63, wave = tid >> 6;
    f32x4 gv[4], bv[4];
#pragma unroll
    for (int j = 0; j < 4; ++j) { gv[j] = *(const f32x4*)(g + 4 * lane + 256 * j); bv[j] = *(const f32x4*)(bta + 4 * lane + 256 * j); }
    for (int m = vcu * NWAVES + wave; m < M; m += G * NWAVES) {
        const f32x4* xr = (const f32x4*)(in + (size_t)m * DM) + lane;
        f32x4 v[4]; float s = 0.f;
#pragma unroll
        for (int j = 0; j < 4; ++j) { v[j] = xr[64 * j]; s += (v[j][0] + v[j][1]) + (v[j][2] + v[j][3]); }
        const float mean = wave_sum(s) * (1.f / DM); float s2 = 0.f;
#pragma unroll
        for (int j = 0; j < 4; ++j) { v[j] = v[j] - mean; s2 += (v[j][0] * v[j][0] + v[j][1] * v[j][1]) + (v[j][2] * v[j][2] + v[j][3] * v[j][3]); }
        const float rstd = 1.f / sqrtf(wave_sum(s2) * (1.f / DM) + LN_EPS);
#pragma unroll
        for (int j = 0; j < 4; ++j) {
            const f32x4 o = v[j] * rstd * gv[j] + bv[j];
            *((f32x4*)(outf + (size_t)m * DM) + lane + 64 * j) = o;
            if (outb) { u32x2 w; w.x = pk2(o[0], o[1]); w.y = pk2(o[2], o[3]); *((u32x2*)(outb + (size_t)m * DM) + lane + 64 * j) = w; }
        }
    }
}

constexpr int N_PHASES = 10;
__global__ void __launch_bounds__(NTHREADS, 2) fwd(Args args) {
    extern __shared__ __attribute__((aligned(16))) unsigned char lds_raw[];
    LAS unsigned char* lds = (LAS unsigned char*)lds_raw;
    const int tid = threadIdx.x, G = gridDim.x, bx = blockIdx.x;
    const int vcu = (G % 8 == 0) ? (bx % 8) * (G / 8) + bx / 8 : bx;
    unsigned char* ws = args.ws;
    bf16_t* Y = (bf16_t*)(ws + WS_Y); bf16_t* MIX = (bf16_t*)(ws + WS_MIX);
    const int lo = args.ph_lo, hi = args.ph_hi;
#ifndef PHMASK
#define PHMASK 0xffff
#endif
#define IN(k) (((PHMASK >> (k)) & 1) && lo <= (k) && (k) < hi)
    if (IN(0)) p0_prologue(args, lds, vcu, G, tid);
    if (IN(1)) {
        pg8::Gemm g{(const bf16_t*)(ws + WS_XB), (const bf16_t*)(ws + WS_WIN), M, INC, DM}; pg8::StaticOrder S; S.init(M, INC, G, bx);
        pg8::EpiInProj E{Y, (const float*)(ws + WS_CS), INC, QSCALE};
        pg8::gemm_phase<pg8::EpiInProj, pg8::StaticOrder, true, true>(lds, g, S, E);
    }
    if (IN(2)) attn_partial_phase(lds, Y, (bf16_t*)(ws + WS_ATTP), (float*)(ws + WS_LSE), vcu, G, tid);
    if (IN(3)) rwkv_direct_phase(lds, args, Y, MIX, vcu, tid);
    if (IN(4)) attn_merge_phase((const bf16_t*)(ws + WS_ATTP), (const float*)(ws + WS_LSE), MIX, vcu, G, tid);
    if (IN(5)) {
        pg8::Gemm g{MIX, (const bf16_t*)(ws + WS_WOUT), M, DM, DM}; pg8::StaticOrder S; S.init(M, DM, G, bx);
        pg8::EpiResF32 E{args.in[I_X], (float*)(ws + WS_TMP5), DM, ALPHA};
        pg8::gemm_phase<pg8::EpiResF32, pg8::StaticOrder, true, true>(lds, g, S, E);
    }
    if (IN(6)) ln_rows_phase((const float*)(ws + WS_TMP5), args.in[I_LN1G], args.in[I_LN1B], args.out, (bf16_t*)(ws + WS_H1B), vcu, G, tid);
    if (IN(7)) {
        pg8::Gemm g{(const bf16_t*)(ws + WS_H1B), (const bf16_t*)(ws + WS_WGU), M, 2 * FF, DM}; pg8::StaticOrder S; S.init(M, 2 * FF, G, bx);
        pg8::EpiSwiGLU E{(bf16_t*)(ws + WS_HID), FF};
        pg8::gemm_phase<pg8::EpiSwiGLU, pg8::StaticOrder, true, true>(lds, g, S, E);
    }
    if (IN(8)) {
        pg8::Gemm g{(const bf16_t*)(ws + WS_HID), (const bf16_t*)(ws + WS_WDN), M, DM, FF}; pg8::StaticOrder S; S.init(M, DM, G, bx);
        pg8::EpiResF32 E{args.out, (float*)(ws + WS_TMP7), DM, ALPHA};
        pg8::gemm_phase<pg8::EpiResF32, pg8::StaticOrder, true, true>(lds, g, S, E);
    }
    if (IN(9)) ln_rows_phase((const float*)(ws + WS_TMP7), args.in[I_LN2G], args.in[I_LN2B], args.out, nullptr, vcu, G, tid);
#undef IN
}

extern "C" void kernel_launch(void* const* d_in, const int* in_sizes, int n_in, void* d_out, int out_size, void* d_ws, size_t ws_size, hipStream_t stream) {
    static int grid = 0;
    if (grid == 0) {
        if (n_in != 22 || out_size != M * DM || ws_size < WS_END) { fprintf(stderr, "kernel_launch: unexpected shapes (n_in %d out %d ws %zu)\n", n_in, out_size, ws_size); grid = -1; return; }
        int dev = 0, cus = 0;
        if (hipGetDevice(&dev) != hipSuccess || hipDeviceGetAttribute(&cus, hipDeviceAttributeMultiprocessorCount, dev) != hipSuccess) { grid = -1; return; }
        if (hipFuncSetAttribute((const void*)fwd, hipFuncAttributeMaxDynamicSharedMemorySize, LDS_BYTES) != hipSuccess) { fprintf(stderr, "kernel_launch: hipFuncSetAttribute failed\n"); grid = -1; return; }
        grid = cus;
    }
    if (grid < 0) return;
    Args a{};
    for (int i = 0; i < 22; ++i) a.in[i] = (const float*)d_in[i];
    a.pos = (const int*)d_in[1]; a.out = (float*)d_out; a.ws = (unsigned char*)d_ws;
    for (int ph = 0; ph < N_PHASES; ++ph) {
        a.ph_lo = ph; a.ph_hi = ph + 1;
        hipLaunchKernelGGL(fwd, dim3(grid), dim3(NTHREADS), LDS_BYTES, stream, a);
    }
}
```

```cpp
#include <hip/hip_runtime.h>
#include <cstdio>
#include <cstdint>
namespace pg8 {
#define PG8_LAS __attribute__((address_space(3)))
typedef unsigned short bf16_t;
typedef short bf16x8 __attribute__((ext_vector_type(8)));
typedef float f32x4 __attribute__((ext_vector_type(4)));
typedef unsigned u32x4 __attribute__((ext_vector_type(4)));
constexpr int BM = 256, BK = 64, HALF = 128, HTB = HALF * BK * 2  , STAGE_BYTES = 8 * HTB, NXCD = 8, WGM = 8;

__host__ __device__ __forceinline__ int lds_byte(int r, int c) { const int st = (r >> 4) * 2 + (c >> 5), rr = r & 15, cc = c & 31, ob = rr * 64 + cc * 2; return st * 1024 + (ob ^ (((ob >> 9) & 1) << 5)); }
__host__ __device__ __forceinline__ void stage_rc(int b, int& R, int& C) { const int st = b / 1024, sb = b % 1024, swz = sb ^ (((sb >> 9) & 1) << 5); R = (st >> 1) * 16 + swz / 64; C = (st & 1) * 32 + (swz % 64) / 2; }
__host__ __device__ __forceinline__ int perm32(int rho) { const int n = rho >> 4, i = rho & 15; return 8 * (i >> 2) + 4 * n + (i & 3); }

struct Unit { int pm, pn; };
struct Gemm { const bf16_t* A; const bf16_t* Bt; int M, N, K; };

struct StaticOrder {
    int nM, nN, nwg, G, c;
    __host__ __device__ void init(int M, int N, int G_, int c_) { nM = M / BM; nN = N / BM; nwg = nM * nN; G = G_; c = c_; }
    __host__ __device__ bool next(int i, Unit& u) const {
        const long L = (long)i * G + c; if (L >= nwg) return false;
        int wgid = (int)L; { const int q = nwg / NXCD, r = nwg % NXCD, xcd = wgid % NXCD, off = wgid / NXCD; wgid = (xcd < r ? xcd * (q + 1) : r * (q + 1) + (xcd - r) * q) + off; }
        const int nig = WGM * nN, gid = wgid / nig, fm = gid * WGM, gsz = (nM - fm) < WGM ? (nM - fm) : WGM;
        u.pm = fm + ((wgid % nig) % gsz); u.pn = (wgid % nig) / gsz; return true;
    }
    __device__ __forceinline__ void a_ready(const Unit&) const {}
    __device__ __forceinline__ void done(const Unit&) const {}
};


__device__ __forceinline__ unsigned cvt_pk_bf16(float lo, float hi) { unsigned r; asm volatile("v_cvt_pk_bf16_f32 %0, %1, %2" : "=v"(r) : "v"(lo), "v"(hi)); return r; }

struct EpiInProj {
    static constexpr bool PERM = true, AFTER_DRAIN = false;
    bf16_t* Y; const float* cs; int ldc; float qscale;
    __device__ __forceinline__ void operator()(const f32x4 (&acc)[2][2][4][2], const Unit& u, int wr, int wc, int fr, int fq) const {
        const int row0 = u.pm * BM + wr * 64 + fr, col0 = u.pn * BM + wc * 32 + 8 * fq;
        const bool rope = (u.pn < 4) && ((wc & 1) == 0);
        const float qs = (u.pn < 2) ? qscale : 1.f;
        const float sg = (fq == 0) ? -1.f : 1.f;
#pragma unroll
        for (int ai = 0; ai < 2; ++ai)
#pragma unroll
            for (int m = 0; m < 4; ++m) {
                const int row = row0 + ai * HALF + m * 16;
                bf16_t* rowp = Y + (size_t)row * ldc + col0;
                f32x4 c0 = {1.f, 1.f, 1.f, 1.f}, c1 = c0, s0 = {0.f, 0.f, 0.f, 0.f}, s1 = s0;
                if (rope) { const f32x4* cp = (const f32x4*)(cs + (size_t)row * 16); c0 = cp[0]; c1 = cp[1]; s0 = cp[2]; s1 = cp[3]; }
#pragma unroll
                for (int bj = 0; bj < 2; ++bj) {
                    f32x4 v0 = acc[ai][bj][m][0], v1 = acc[ai][bj][m][1];
                    if (rope) {
                        f32x4 o0, o1;
#pragma unroll
                        for (int e = 0; e < 4; ++e) { o0[e] = __shfl_xor(v0[e], 16); o1[e] = __shfl_xor(v1[e], 16); }
                        const f32x4 r0 = v0 * c0 + (o0 * s0) * sg, r1 = v1 * c1 + (o1 * s1) * sg;
                        if (fq < 2) { v0 = r0; v1 = r1; }
                    }
                    v0 = v0 * qs; v1 = v1 * qs;
                    u32x4 w; w.x = cvt_pk_bf16(v0[0], v0[1]); w.y = cvt_pk_bf16(v0[2], v0[3]); w.z = cvt_pk_bf16(v1[0], v1[1]); w.w = cvt_pk_bf16(v1[2], v1[3]);
                    *(u32x4*)(rowp + bj * HALF) = w;
                }
            }
    }
};

struct EpiSwiGLU {
    static constexpr bool PERM = true, AFTER_DRAIN = false;
    bf16_t* H; int ldc;
    __device__ __forceinline__ void operator()(const f32x4 (&acc)[2][2][4][2], const Unit& u, int wr, int wc, int fr, int fq) const {
        const int row0 = u.pm * BM + wr * 64 + fr, col0 = u.pn * HALF + wc * 32 + 8 * fq;
#pragma unroll
        for (int ai = 0; ai < 2; ++ai)
#pragma unroll
            for (int m = 0; m < 4; ++m) {
                bf16_t* rowp = H + (size_t)(row0 + ai * HALF + m * 16) * ldc + col0;
                float h[8];
#pragma unroll
                for (int n = 0; n < 2; ++n)
#pragma unroll
                    for (int e = 0; e < 4; ++e) { const float g = acc[ai][0][m][n][e], up = acc[ai][1][m][n][e];
                        const float sig = __builtin_amdgcn_rcpf(1.f + __builtin_amdgcn_exp2f(-1.4426950408889634f * g)); h[n * 4 + e] = g * sig * up; }
                u32x4 w; w.x = cvt_pk_bf16(h[0], h[1]); w.y = cvt_pk_bf16(h[2], h[3]); w.z = cvt_pk_bf16(h[4], h[5]); w.w = cvt_pk_bf16(h[6], h[7]);
                *(u32x4*)rowp = w;
            }
    }
};

struct EpiResF32 {
    static constexpr bool PERM = false, AFTER_DRAIN = false;
    const float* base; float* out; int ldc; float alpha;
    __device__ __forceinline__ void operator()(const f32x4 (&acc)[2][2][4][2], const Unit& u, int wr, int wc, int fr, int fq) const {
        const int row0 = u.pm * BM + wr * 64 + fr, col0 = u.pn * BM + wc * 32 + 4 * fq;
#pragma unroll
        for (int ai = 0; ai < 2; ++ai)
#pragma unroll
            for (int m = 0; m < 4; ++m) { const size_t off = (size_t)(row0 + ai * HALF + m * 16) * ldc + col0;
#pragma unroll
                for (int bj = 0; bj < 2; ++bj)
#pragma unroll
                    for (int n = 0; n < 2; ++n) { const f32x4 bs = *(const f32x4*)(base + off + bj * HALF + n * 16); *(f32x4*)(out + off + bj * HALF + n * 16) = bs * alpha + acc[ai][bj][m][n]; } }
    }
};

template <class Epi, class Sched, bool ALIGN_EPI = false, bool SP2 = false>
__device__ __forceinline__ void gemm_phase(PG8_LAS unsigned char* lds, const Gemm g, const Sched& S, const Epi& E) {
    const int tid = threadIdx.x, wid = __builtin_amdgcn_readfirstlane(tid >> 6), lane = tid & 63, wr = wid >> 2, wc = wid & 3, fr = lane & 15, fq = lane >> 4;
    const int K = g.K, nt = K / BK;
    unsigned voffA[2], voffB[2];
#pragma unroll
    for (int i = 0; i < 2; ++i) { int R, C; stage_rc(tid * 16 + i * 8192, R, C); const int Rb = Epi::PERM ? ((R & ~31) + perm32(R & 31)) : R;
        voffA[i] = (unsigned)(R * K + C) * 2u; voffB[i] = (unsigned)(Rb * K + C) * 2u; }
    const size_t kstep = (size_t)(BK * 2);
    const size_t hstep = (size_t)HALF * K * 2;
    const size_t tstep = 2 * hstep;
    const unsigned ldsw = (unsigned)wid * 1024u;
    const int aoff = lds_byte(wr * 64 + fr, fq * 8), boff = lds_byte(wc * 32 + fr, fq * 8);
#define PG8_SA(b, h) (((b) * 2 + (h)) * HTB)
#define PG8_SB(b, h) ((4 + (b) * 2 + (h)) * HTB)
#define PG8_STAGE(bufoff, gbase, voff) do { _Pragma("unroll") for (int _i = 0; _i < 2; ++_i) \
        __builtin_amdgcn_global_load_lds((const unsigned*)((const char*)(gbase) + (voff)[_i]), (PG8_LAS unsigned*)(lds + (bufoff) + ldsw + _i * 8192), 16, 0, 0); } while (0)
#define PG8_LDA(dst, b, h) do { _Pragma("unroll") for (int m = 0; m < 4; ++m) _Pragma("unroll") for (int k = 0; k < 2; ++k) dst[m][k] = *(const PG8_LAS bf16x8*)(lds + PG8_SA(b, h) + aoff + m * 2048 + k * 1024); } while (0)
#define PG8_LDB(dst, b, h) do { _Pragma("unroll") for (int n = 0; n < 2; ++n) _Pragma("unroll") for (int k = 0; k < 2; ++k) dst[n][k] = *(const PG8_LAS bf16x8*)(lds + PG8_SB(b, h) + boff + n * 2048 + k * 1024); } while (0)
#define PG8_MMA(ai, bj, At, Bt) do { __builtin_amdgcn_s_setprio(1); _Pragma("unroll") for (int m = 0; m < 4; ++m) _Pragma("unroll") for (int n = 0; n < 2; ++n) _Pragma("unroll") for (int k = 0; k < 2; ++k) \
        acc[ai][bj][m][n] = __builtin_amdgcn_mfma_f32_16x16x32_bf16(Bt[n][k], At[m][k], acc[ai][bj][m][n], 0, 0, 0); __builtin_amdgcn_s_setprio(0); } while (0)
#define PG8_WAIT_V(n) asm volatile("s_waitcnt vmcnt(" #n ")" ::: "memory")
#define PG8_WAIT_L(n) asm volatile("s_waitcnt lgkmcnt(" #n ")" ::: "memory")
#define PG8_BAR __builtin_amdgcn_s_barrier()
#define PG8_SCHED __builtin_amdgcn_sched_barrier(0)
    Unit cur, nxt; int ui = 0;
    if (!S.next(0, cur)) return;
    f32x4 acc[2][2][4][2];
#pragma unroll
    for (int a = 0; a < 2; ++a)
#pragma unroll
        for (int b = 0; b < 2; ++b)
#pragma unroll
            for (int m = 0; m < 4; ++m)
#pragma unroll
                for (int n = 0; n < 2; ++n) acc[a][b][m][n] = (f32x4){0.f, 0.f, 0.f, 0.f};
    bf16x8 At[4][2], B0[2][2], B1[2][2];
    const char* cA = (const char*)g.A + (size_t)cur.pm * tstep; const char* cB = (const char*)g.Bt + (size_t)cur.pn * tstep;
    S.a_ready(cur);
    if constexpr (SP2) {
        PG8_STAGE(PG8_SB(0, 0), cB, voffB); PG8_STAGE(PG8_SB(0, 1), cB + hstep, voffB); PG8_STAGE(PG8_SA(0, 0), cA, voffA); PG8_STAGE(PG8_SA(0, 1), cA + hstep, voffA);
        if (wr == 1) PG8_BAR;
        PG8_WAIT_V(2); PG8_BAR;
        PG8_STAGE(PG8_SB(1, 0), cB + kstep, voffB); PG8_STAGE(PG8_SA(1, 0), cA + kstep, voffA); PG8_STAGE(PG8_SB(1, 1), cB + hstep + kstep, voffB);
        PG8_WAIT_V(6); PG8_BAR;
    } else {
        PG8_STAGE(PG8_SB(0, 0), cB, voffB); PG8_STAGE(PG8_SA(0, 0), cA, voffA); PG8_STAGE(PG8_SB(0, 1), cB + hstep, voffB); PG8_STAGE(PG8_SA(0, 1), cA + hstep, voffA);
        if (wr == 1) PG8_BAR;
        PG8_WAIT_V(4); PG8_BAR;
        PG8_STAGE(PG8_SB(1, 0), cB + kstep, voffB); PG8_STAGE(PG8_SA(1, 0), cA + kstep, voffA); PG8_STAGE(PG8_SB(1, 1), cB + hstep + kstep, voffB);
        PG8_WAIT_V(6); PG8_BAR;
    }
    for (;;) {
        const bool has_next = S.next(ui + 1, nxt);
        const char* nA = has_next ? (const char*)g.A + (size_t)nxt.pm * tstep : cA; const char* nB = has_next ? (const char*)g.Bt + (size_t)nxt.pn * tstep : cB;
        for (int t = 0; t < nt; t += 2) {
            const bool last = (t == nt - 2);
            const char* a1 = cA + (size_t)(t + 1) * kstep;
            const char* a2 = last ? nA : cA + (size_t)(t + 2) * kstep; const char* b2 = last ? nB : cB + (size_t)(t + 2) * kstep;
            const char* a3 = a2 + kstep; const char* b3 = b2 + kstep;
            if (last && has_next) S.a_ready(nxt);
            if constexpr (SP2) {
            PG8_LDB(B0, 0, 0); PG8_LDB(B1, 0, 1); PG8_SCHED; PG8_LDA(At, 0, 0); PG8_STAGE(PG8_SA(1, 1), a1 + hstep, voffA);
            PG8_WAIT_V(8); PG8_WAIT_L(0); PG8_BAR; PG8_MMA(0, 0, At, B0); PG8_MMA(0, 1, At, B1); PG8_BAR; PG8_SCHED;
            PG8_LDA(At, 0, 1); PG8_STAGE(PG8_SB(0, 0), b2, voffB); PG8_STAGE(PG8_SB(0, 1), b2 + hstep, voffB); PG8_STAGE(PG8_SA(0, 0), a2, voffA);
            PG8_WAIT_V(8); PG8_WAIT_L(0); PG8_BAR; PG8_MMA(1, 0, At, B0); PG8_MMA(1, 1, At, B1); PG8_BAR; PG8_SCHED;
            PG8_LDB(B0, 1, 0); PG8_LDB(B1, 1, 1); PG8_SCHED; PG8_LDA(At, 1, 0); PG8_STAGE(PG8_SA(0, 1), a2 + hstep, voffA);
            PG8_WAIT_V(8); PG8_WAIT_L(0); PG8_BAR; PG8_MMA(0, 0, At, B0); PG8_MMA(0, 1, At, B1); PG8_BAR; PG8_SCHED;
            PG8_LDA(At, 1, 1); PG8_STAGE(PG8_SB(1, 0), b3, voffB); PG8_STAGE(PG8_SB(1, 1), b3 + hstep, voffB); PG8_STAGE(PG8_SA(1, 0), a3, voffA);
            PG8_WAIT_V(8); PG8_WAIT_L(0); PG8_BAR; PG8_MMA(1, 0, At, B0); PG8_MMA(1, 1, At, B1); PG8_BAR; PG8_SCHED;
            } else {
            PG8_LDB(B0, 0, 0); PG8_SCHED; PG8_LDA(At, 0, 0); PG8_STAGE(PG8_SA(1, 1), a1 + hstep, voffA);
            PG8_WAIT_L(8); PG8_BAR; PG8_WAIT_L(0); PG8_MMA(0, 0, At, B0); PG8_BAR; PG8_SCHED;
            PG8_LDB(B1, 0, 1); PG8_STAGE(PG8_SB(0, 0), b2, voffB);
            PG8_BAR; PG8_WAIT_L(0); PG8_MMA(0, 1, At, B1); PG8_BAR;
            PG8_LDA(At, 0, 1); PG8_STAGE(PG8_SA(0, 0), a2, voffA);
            PG8_BAR; PG8_WAIT_L(0); PG8_MMA(1, 0, At, B0); PG8_BAR; PG8_SCHED;
            PG8_STAGE(PG8_SB(0, 1), b2 + hstep, voffB);
            PG8_WAIT_V(6); PG8_BAR; PG8_MMA(1, 1, At, B1); PG8_BAR;
            PG8_LDB(B0, 1, 0); PG8_SCHED; PG8_LDA(At, 1, 0); PG8_STAGE(PG8_SA(0, 1), a2 + hstep, voffA);
            PG8_WAIT_L(8); PG8_BAR; PG8_WAIT_L(0); PG8_MMA(0, 0, At, B0); PG8_BAR; PG8_SCHED;
            PG8_LDB(B1, 1, 1); PG8_STAGE(PG8_SB(1, 0), b3, voffB);
            PG8_BAR; PG8_WAIT_L(0); PG8_MMA(0, 1, At, B1); PG8_BAR;
            PG8_LDA(At, 1, 1); PG8_STAGE(PG8_SA(1, 0), a3, voffA);
            PG8_BAR; PG8_WAIT_L(0); PG8_MMA(1, 0, At, B0); PG8_BAR; PG8_SCHED;
            PG8_STAGE(PG8_SB(1, 1), b3 + hstep, voffB);
            PG8_WAIT_V(6); PG8_BAR; PG8_MMA(1, 1, At, B1); PG8_BAR;
            }
        }
        if constexpr (ALIGN_EPI) { if (wr == 0) PG8_BAR; }
        if constexpr (!Epi::AFTER_DRAIN) { E(acc, cur, wr, wc, fr, fq); S.done(cur); }
        if (!has_next) break;
#pragma unroll
        for (int a = 0; a < 2; ++a)
#pragma unroll
            for (int b = 0; b < 2; ++b)
#pragma unroll
                for (int m = 0; m < 4; ++m)
#pragma unroll
                    for (int n = 0; n < 2; ++n) acc[a][b][m][n] = (f32x4){0.f, 0.f, 0.f, 0.f};
        cur = nxt; cA = nA; cB = nB; ++ui;
        if constexpr (ALIGN_EPI) { if (wr == 1) PG8_BAR; }
    }
    PG8_WAIT_V(0);
    if constexpr (!ALIGN_EPI) { if (wr == 0) PG8_BAR; }
    PG8_BAR;
    if constexpr (Epi::AFTER_DRAIN) { E.fused(acc, cur, wr, wc, fr, fq, lds, wid, lane); S.done(cur); }
#undef PG8_SA
#undef PG8_SB
#undef PG8_STAGE
#undef PG8_LDA
#undef PG8_LDB
#undef PG8_MMA
#undef PG8_WAIT_V
#undef PG8_WAIT_L
#undef PG8_BAR
#undef PG8_SCHED
}
}

#define LAS __attribute__((address_space(3)))
typedef unsigned short bf16_t;
typedef short bf16x8 __attribute__((ext_vector_type(8)));
typedef short s16x4 __attribute__((ext_vector_type(4)));
typedef float f32x4 __attribute__((ext_vector_type(4)));
typedef float f32x16 __attribute__((ext_vector_type(16)));
typedef unsigned u32x2 __attribute__((ext_vector_type(2)));
typedef unsigned u32x4 __attribute__((ext_vector_type(4)));

constexpr int NB = 4, SEQ = 8192, DM = 1024, M = NB * SEQ, INC = 3328, FF = 2816, NH = 8, HD = 64;
constexpr int C_Q = 0, C_K = 512, C_V = 1024, C_RW = 1536, C_R = 1536, C_KR = 2048, C_VR = 2560, C_DW = 3072, C_DA = 3136, C_DG = 3200;
constexpr float ALPHA = 1.189207115002721f;
constexpr float LN_EPS = 1e-5f, GN_EPS = 64e-5f, L2_EPS = 1e-6f;
constexpr float DECAY_SCALE = 0.6065306597126334f;
constexpr float LOG2E = 1.4426950408889634f;
constexpr float QSCALE = 0.125f * LOG2E;
constexpr int NWAVES = 8, NTHREADS = 512;

constexpr size_t MiB = 1u << 20;
constexpr size_t WS_CTL = 0, CTL_ZERO_BYTES = 1 * MiB;
constexpr size_t WS_WIN = 1 * MiB, WS_WOUT = 8 * MiB, WS_WGU = 10 * MiB, WS_WDN = 21 * MiB, WS_CS = 28 * MiB;
constexpr size_t WS_Y = 32 * MiB;
constexpr size_t WS_HID = 32 * MiB;
constexpr size_t WS_TMP5 = 32 * MiB;
constexpr size_t WS_XB = 240 * MiB;
constexpr size_t WS_ATTP = 240 * MiB;
constexpr size_t WS_TMP7 = 240 * MiB;
constexpr size_t WS_LSE = 336 * MiB;
constexpr size_t WS_MIX = 340 * MiB;
constexpr size_t WS_H1B = 404 * MiB;
constexpr size_t WS_END = 468 * MiB;

constexpr int LDS_BYTES = 147456;

__device__ __forceinline__ unsigned f2bf(float f) { unsigned u = __builtin_bit_cast(unsigned, f); return (u + 0x7fffu + ((u >> 16) & 1u)) >> 16; }
__device__ __forceinline__ unsigned pk2(float lo, float hi) { return f2bf(lo) | (f2bf(hi) << 16); }
__device__ __forceinline__ float bf2f(unsigned b) { return __builtin_bit_cast(float, b << 16); }
__device__ __forceinline__ float sigmoidf_(float x) { return 1.f / (1.f + __expf(-x)); }
#define LDS_WAIT() asm volatile("s_waitcnt lgkmcnt(0)" ::: "memory")

struct Args {
    const float* in[22]; const int* pos; float* out; unsigned char* ws; int ph_lo, ph_hi, pad0, pad1;
};
enum { I_X = 0, I_POS = 1, I_WIN = 2, I_WOUT = 3, I_MU = 4, I_W0 = 5, I_WD = 6, I_A0 = 7, I_WA = 8, I_WG = 9, I_KK = 10, I_KA = 11, I_RK = 12, I_GNG = 13, I_GNB = 14,
       I_LN1G = 15, I_LN1B = 16, I_FG = 17, I_FU = 18, I_FD = 19, I_LN2G = 20, I_LN2B = 21 };

__device__ __forceinline__ void p0_transpose_item(const float* W, int K, int N, bf16_t* WT, int dst_row0, LAS float* scr, int k0, int n0, int lane) {
#pragma unroll 8
    for (int i = 0; i < 32; ++i) { const int kk = 2 * i + (lane >> 5); scr[kk * 33 + (lane & 31)] = W[(size_t)(k0 + kk) * N + n0 + (lane & 31)]; }
    LDS_WAIT();
    const int c = lane & 7;
#pragma unroll
    for (int j = 0; j < 4; ++j) { const int n = (lane >> 3) + 8 * j; const LAS float* s = scr + (8 * c) * 33 + n;
        u32x4 o; o.x = pk2(s[0 * 33], s[1 * 33]); o.y = pk2(s[2 * 33], s[3 * 33]); o.z = pk2(s[4 * 33], s[5 * 33]); o.w = pk2(s[6 * 33], s[7 * 33]);
        *(u32x4*)(WT + (size_t)(dst_row0 + n) * K + k0 + 8 * c) = o; }
    LDS_WAIT();
}

__device__ __forceinline__ void sincos_rev(float angf, float& c, float& s) {
    const double a = (double)angf;
    double r = a * 0.15915494309189535; r = r - floor(r); if (r >= 0.5) r -= 1.0;
    const double x = r * 6.283185307179586, x2 = x * x;
    double sc = 1.0, ss = 1.0;
    sc = 1.0; ss = 1.0;
#pragma unroll
    for (int k = 13; k >= 1; --k) { sc = 1.0 - sc * x2 * (1.0 / (double)((2 * k - 1) * (2 * k))); ss = 1.0 - ss * x2 * (1.0 / (double)((2 * k) * (2 * k + 1))); }
    c = (float)sc; s = (float)(ss * x);
}

__device__ __forceinline__ void p0_prologue(const Args& A, LAS unsigned char* lds, int vcu, int G, int tid) {
    const int lane = tid & 63, wave = tid >> 6;
    unsigned char* ws = A.ws;
    LAS float* scr = (LAS float*)(lds + wave * 16384);
    const int gw = vcu * NWAVES + wave, NGW = G * NWAVES;
    constexpr int I_IN = (DM / 64) * (INC / 32), I_OUT = (DM / 64) * (DM / 32), I_G = (DM / 64) * (FF / 32), I_D = (FF / 64) * (DM / 32);
    constexpr int NITEMS = I_IN + I_OUT + 2 * I_G + I_D;
    for (int it = gw; it < NITEMS; it += NGW) {
        int r = it;
        if (r < I_IN) { const int nb = INC / 32, kb = r / nb, n0 = 32 * (r % nb); p0_transpose_item(A.in[I_WIN], DM, INC, (bf16_t*)(ws + WS_WIN), n0, scr, 64 * kb, n0, lane); continue; } r -= I_IN;
        if (r < I_OUT) { const int nb = DM / 32, kb = r / nb, n0 = 32 * (r % nb); p0_transpose_item(A.in[I_WOUT], DM, DM, (bf16_t*)(ws + WS_WOUT), n0, scr, 64 * kb, n0, lane); continue; } r -= I_OUT;
        if (r < 2 * I_G) { const int up = r >= I_G; if (up) r -= I_G; const int nb = FF / 32, kb = r / nb, n0 = 32 * (r % nb);
            p0_transpose_item(A.in[up ? I_FU : I_FG], DM, FF, (bf16_t*)(ws + WS_WGU), 256 * (n0 / 128) + (n0 % 128) + (up ? 128 : 0), scr, 64 * kb, n0, lane); continue; } r -= 2 * I_G;
        { const int nb = DM / 32, kb = r / nb, n0 = 32 * (r % nb); p0_transpose_item(A.in[I_FD], FF, DM, (bf16_t*)(ws + WS_WDN), n0, scr, 64 * kb, n0, lane); }
    }
    { const float* x = A.in[I_X]; bf16_t* xb = (bf16_t*)(ws + WS_XB);
      const size_t n8 = (size_t)M * DM / 8;
      for (size_t i = (size_t)vcu * NTHREADS + tid; i < n8; i += (size_t)G * NTHREADS) {
          const f32x4 a = *(const f32x4*)(x + i * 8), b = *(const f32x4*)(x + i * 8 + 4);
          u32x4 o; o.x = pk2(a[0], a[1]); o.y = pk2(a[2], a[3]); o.z = pk2(b[0], b[1]); o.w = pk2(b[2], b[3]);
          *(u32x4*)(xb + i * 8) = o; } }
    { float* cs = (float*)(ws + WS_CS);
      for (int i = vcu * NTHREADS + tid; i < M * 8; i += G * NTHREADS) {
          const int m = i >> 3, f = i & 7;
          const float invf[8] = {1.0f, 0.1939227432012558f, 0.03760603070259094f, 0.007292664609849453f, 0.0014142135623842478f, 0.00027424818836152554f, 5.318296098266728e-05f, 1.0313386155758053e-05f};
          float fr = invf[0];
#pragma unroll
          for (int q = 1; q < 8; ++q) fr = (f == q) ? invf[q] : fr;
          const float ang = (float)A.pos[m] * fr;
          float c, s; sincos_rev(ang, c, s);
          cs[(size_t)m * 16 + f] = c; cs[(size_t)m * 16 + 8 + f] = s; } }
}

__device__ __forceinline__ int crow(int r, int hi) { return (r & 3) + 8 * (r >> 2) + 4 * hi; }
typedef short v4i16_t __attribute__((ext_vector_type(4)));
__device__ __forceinline__ s16x4 vtr(const LAS unsigned char* p) { return __builtin_bit_cast(s16x4, __builtin_amdgcn_ds_read_tr16_b64_v4i16((LAS v4i16_t*)p)); }

constexpr int ATT_KROWS = 384;
constexpr int ATT_LK = 0, ATT_LV = ATT_KROWS * 128, ATT_LW = 2 * ATT_KROWS * 128, ATT_WSCR = 4096 + 256;

__device__ __forceinline__ void attn_partial_phase(LAS unsigned char* lds, const bf16_t* Y, bf16_t* OP, float* LSE, int vcu, int G, int tid) {
    const int lane = tid & 63, wid = __builtin_amdgcn_readfirstlane(tid >> 6), r32 = lane & 31, hi = lane >> 5;
    LAS unsigned char* Kimg = lds + ATT_LK; LAS unsigned char* Vimg = lds + ATT_LV;
    LAS unsigned char* wscr = lds + ATT_LW + wid * ATT_WSCR;
    LAS float* wsf = (LAS float*)(wscr + 4096);
    for (int unit = vcu; unit < 32 * 96; unit += G) {
        const int bh = unit / 96, rem = unit % 96, p = rem >> 5, j = rem & 31;
        const int b = bh >> 3, h = bh & 7;
        const int dl = 2 * p, d = 1 << dl;
        const int nblk = 32 >> dl;
        const int rcls = j / nblk, i0 = (j % nblk) * 256;
        const size_t rowb = (size_t)b * SEQ;
        for (int idx = tid; idx < ATT_KROWS * 8; idx += NTHREADS) {
            const int row = idx >> 3, ch = idx & 7, ci = i0 - 128 + row;
            u32x4 kv = {0u, 0u, 0u, 0u}, vv = kv;
            if (ci >= 0) { const bf16_t* pp = Y + (rowb + (size_t)ci * d + rcls) * INC + h * HD + ch * 8; kv = *(const u32x4*)(pp + C_K); vv = *(const u32x4*)(pp + C_V); }
            *(LAS u32x4*)(Kimg + row * 128 + ((ch ^ ((row >> 1) & 7)) << 4)) = kv;
            *(LAS u32x4*)(Vimg + row * 128 + ((ch ^ (((row >> 1) & 1) << 2)) << 4)) = vv;
        }
        __syncthreads();
        const int qidx = i0 + 32 * wid + r32;
        const bf16_t* qptr = Y + (rowb + (size_t)qidx * d + rcls) * INC + C_Q + h * HD;
        bf16x8 qf[4];
#pragma unroll
        for (int d0 = 0; d0 < 4; ++d0) qf[d0] = *(const bf16x8*)(qptr + 16 * d0 + 8 * hi);
        f32x16 pt[5];
#pragma unroll
        for (int kt = 0; kt < 5; ++kt) {
            f32x16 acc = {};
            const int row = 32 * wid + 32 * kt + r32;
#pragma unroll
            for (int d0 = 0; d0 < 4; ++d0) {
                const int ch = 2 * d0 + hi;
                const bf16x8 kf = *(const LAS bf16x8*)(Kimg + row * 128 + ((ch ^ ((row >> 1) & 7)) << 4));
                acc = __builtin_amdgcn_mfma_f32_32x32x16_bf16(kf, qf[d0], acc, 0, 0, 0);
            }
            pt[kt] = acc;
        }
        float mx = -INFINITY;
#pragma unroll
        for (int kt = 0; kt < 5; ++kt)
#pragma unroll
            for (int r = 0; r < 16; ++r) {
                const int cr = crow(r, hi);
                const int delta = 128 - 32 * kt + r32 - cr;
                const int kidx = i0 - 128 + 32 * wid + 32 * kt + cr;
                const bool valid = (delta >= 0) && (delta <= 128) && (kidx >= 0);
                float v = pt[kt][r]; v = valid ? v : -INFINITY; pt[kt][r] = v; mx = fmaxf(mx, v);
            }
        mx = fmaxf(mx, __shfl_xor(mx, 32));
        float l = 0.f;
#pragma unroll
        for (int kt = 0; kt < 5; ++kt)
#pragma unroll
            for (int r = 0; r < 16; ++r) { const float e = __builtin_amdgcn_exp2f(pt[kt][r] - mx); pt[kt][r] = e; l += e; }
        l += __shfl_xor(l, 32);
        f32x16 o[2]; o[0] = f32x16{}; o[1] = f32x16{};
        const int g1 = (lane >> 4) & 1, q4 = (lane & 15) >> 2, p4 = lane & 3;
#pragma unroll
        for (int kt = 0; kt < 5; ++kt)
#pragma unroll
            for (int s = 0; s < 2; ++s) {
                u32x4 pw;
                pw.x = pk2(pt[kt][8 * s + 0], pt[kt][8 * s + 1]); pw.y = pk2(pt[kt][8 * s + 2], pt[kt][8 * s + 3]);
                pw.z = pk2(pt[kt][8 * s + 4], pt[kt][8 * s + 5]); pw.w = pk2(pt[kt][8 * s + 6], pt[kt][8 * s + 7]);
                const bf16x8 pa = __builtin_bit_cast(bf16x8, pw);
                const int rlo = 32 * wid + 32 * kt + 16 * s + 4 * hi + q4, rhi = rlo + 8;
#pragma unroll
                for (int dh = 0; dh < 2; ++dh) {
                    const int chunk = 4 * dh + 2 * g1 + (p4 >> 1), sub = 8 * (p4 & 1);
                    const s16x4 vlo = vtr(Vimg + rlo * 128 + ((chunk ^ (((rlo >> 1) & 1) << 2)) << 4) + sub);
                    const s16x4 vhi = vtr(Vimg + rhi * 128 + ((chunk ^ (((rhi >> 1) & 1) << 2)) << 4) + sub);
                    const bf16x8 vf = (bf16x8){vlo[0], vlo[1], vlo[2], vlo[3], vhi[0], vhi[1], vhi[2], vhi[3]};
                    o[dh] = __builtin_amdgcn_mfma_f32_32x32x16_bf16(pa, vf, o[dh], 0, 0, 0);
                }
            }
        if (hi == 0) wsf[r32] = l;
        LDS_WAIT();
        bf16_t LAS* stg = (bf16_t LAS*)wscr;
#pragma unroll
        for (int r = 0; r < 16; ++r) {
            const int q = crow(r, hi); const float rl = 1.f / wsf[q];
            stg[q * 64 + r32] = (bf16_t)f2bf(o[0][r] * rl); stg[q * 64 + 32 + r32] = (bf16_t)f2bf(o[1][r] * rl);
        }
        LDS_WAIT();
        bf16_t* OPp = OP + (size_t)p * M * 512;
#pragma unroll
        for (int i = 0; i < 4; ++i) {
            const int q = i * 8 + (lane >> 3), ch = lane & 7;
            const u32x4 v = *(const LAS u32x4*)(wscr + q * 128 + ch * 16);
            const size_t tok = rowb + (size_t)(i0 + 32 * wid + q) * d + rcls;
            *(u32x4*)(OPp + tok * 512 + h * HD + ch * 8) = v;
        }
        if (hi == 0) { const size_t tok = rowb + (size_t)qidx * d + rcls; LSE[(size_t)p * M * 8 + tok * 8 + h] = mx + __log2f(l); }
        __syncthreads();
    }
}

__device__ __forceinline__ void attn_merge_phase(const bf16_t* OP, const float* LSE, bf16_t* MIX, int vcu, int G, int tid) {
    const size_t total = (size_t)M * 64;
    for (size_t i = (size_t)vcu * NTHREADS + tid; i < total; i += (size_t)G * NTHREADS) {
        const size_t tok = i >> 6; const int hc = (int)(i & 63), h = hc >> 3;
        const float l0 = LSE[tok * 8 + h], l1 = LSE[(size_t)M * 8 + tok * 8 + h], l2 = LSE[(size_t)2 * M * 8 + tok * 8 + h];
        const float mx = fmaxf(l0, fmaxf(l1, l2));
        float w0 = __builtin_amdgcn_exp2f(l0 - mx), w1 = __builtin_amdgcn_exp2f(l1 - mx), w2 = __builtin_amdgcn_exp2f(l2 - mx);
        const float inv = 1.f / (w0 + w1 + w2); w0 *= inv; w1 *= inv; w2 *= inv;
        const u32x4 a = *(const u32x4*)(OP + tok * 512 + hc * 8), bq = *(const u32x4*)(OP + (size_t)M * 512 + tok * 512 + hc * 8), c = *(const u32x4*)(OP + (size_t)2 * M * 512 + tok * 512 + hc * 8);
        u32x4 o;
#pragma unroll
        for (int e = 0; e < 4; ++e) {
            const float lo = w0 * bf2f(a[e] & 0xffffu) + w1 * bf2f(bq[e] & 0xffffu) + w2 * bf2f(c[e] & 0xffffu);
            const float hi = w0 * bf2f(a[e] >> 16) + w1 * bf2f(bq[e] >> 16) + w2 * bf2f(c[e] >> 16);
            o[e] = pk2(lo, hi);
        }
        *(u32x4*)(MIX + tok * DM + hc * 8) = o;
    }
}

__device__ __forceinline__ float ysh(const bf16_t* Y, size_t row, int t, int col, const float* mu) {
    const float yc = bf2f(Y[row * INC + col]); const float yp = (t > 0) ? bf2f(Y[(row - 1) * INC + col]) : 0.f;
    return yc + mu[col - C_RW] * (yp - yc);
}
__device__ __forceinline__ void rwkv_direct_phase(LAS unsigned char* lds, const Args& A, const bf16_t* Y, bf16_t* MIX, int vcu, int tid) {
    if (vcu >= 32) return;
    const int b = vcu >> 3, h = vcu & 7;
    LAS float* LIN = (LAS float*)lds;
    LAS float* RR = LIN + 32 * 256;
    LAS float* WW = RR + 2048; LAS float* KM = WW + 2048; LAS float* VV = KM + 2048; LAS float* AV = VV + 2048; LAS float* BV = AV + 2048; LAS float* GG = BV + 2048; LAS float* OB = GG + 2048;
    LAS float* BON = OB + 2048;
    const float* mu = A.in[I_MU];
    float s[8];
#pragma unroll
    for (int i = 0; i < 8; ++i) s[i] = 0.f;
#pragma unroll 1
    for (int ci = 0; ci < SEQ / 32; ++ci) {
        const int t0 = ci * 32; const size_t row0 = (size_t)b * SEQ + t0;
        for (int idx = tid; idx < 32 * 256; idx += NTHREADS) {
            const int tok = idx >> 8, c = idx & 255;
            float v = ysh(Y, row0 + tok, t0 + tok, C_DW + c, mu);
            if (c < 64) v = tanhf(v); else if (c >= 128) v = sigmoidf_(v);
            LIN[idx] = v;
        }
        __syncthreads();
        {
            const int tok = tid >> 4, jg = tid & 15, j0 = 4 * jg, cj = h * 64 + j0;
            float wl[4], al[4], gl[4];
#pragma unroll
            for (int e = 0; e < 4; ++e) { wl[e] = A.in[I_W0][cj + e]; al[e] = A.in[I_A0][cj + e]; gl[e] = 0.f; }
            const LAS float* li = LIN + tok * 256;
#pragma unroll 2
            for (int i = 0; i < 64; ++i) {
                const f32x4 wd = *(const f32x4*)(A.in[I_WD] + (size_t)i * 512 + cj), wa = *(const f32x4*)(A.in[I_WA] + (size_t)i * 512 + cj);
                const float x1 = li[i], x2 = li[64 + i];
#pragma unroll
                for (int e = 0; e < 4; ++e) { wl[e] += x1 * wd[e]; al[e] += x2 * wa[e]; }
            }
#pragma unroll 2
            for (int i = 0; i < 128; ++i) {
                const f32x4 wg = *(const f32x4*)(A.in[I_WG] + (size_t)i * 512 + cj); const float x3 = li[128 + i];
#pragma unroll
                for (int e = 0; e < 4; ++e) gl[e] += x3 * wg[e];
            }
            float r[4], kr[4], vr[4], kk[4]; float n2 = 0.f;
#pragma unroll
            for (int e = 0; e < 4; ++e) {
                r[e] = ysh(Y, row0 + tok, t0 + tok, C_R + cj + e, mu); kr[e] = ysh(Y, row0 + tok, t0 + tok, C_KR + cj + e, mu); vr[e] = ysh(Y, row0 + tok, t0 + tok, C_VR + cj + e, mu);
                kk[e] = kr[e] * A.in[I_KK][cj + e]; n2 += kk[e] * kk[e];
            }
            n2 += __shfl_xor(n2, 1); n2 += __shfl_xor(n2, 2); n2 += __shfl_xor(n2, 4); n2 += __shfl_xor(n2, 8);
            const float inv = 1.f / fmaxf(sqrtf(n2), L2_EPS);
            float bon = 0.f;
#pragma unroll
            for (int e = 0; e < 4; ++e) {
                const float a = sigmoidf_(al[e]); const float dec = __expf(-DECAY_SCALE * sigmoidf_(wl[e]));
                const float kn = kk[e] * inv; const float km = kr[e] * (1.f + (a - 1.f) * A.in[I_KA][cj + e]);
                bon += r[e] * km * A.in[I_RK][cj + e];
                const int o = tok * 64 + j0 + e;
                RR[o] = r[e]; WW[o] = dec; KM[o] = km; VV[o] = vr[e]; AV[o] = -kn; BV[o] = kn * a; GG[o] = gl[e];
            }
            bon += __shfl_xor(bon, 1); bon += __shfl_xor(bon, 2); bon += __shfl_xor(bon, 4); bon += __shfl_xor(bon, 8);
            if (jg == 0) BON[tok] = bon;
        }
        __syncthreads();
        {
            const int v = tid >> 3, kq = tid & 7;
#pragma unroll 1
            for (int t = 0; t < 32; ++t) {
                const int o = t * 64 + 8 * kq;
                const f32x4 a0 = *(const LAS f32x4*)(AV + o), a1 = *(const LAS f32x4*)(AV + o + 4), w0 = *(const LAS f32x4*)(WW + o), w1 = *(const LAS f32x4*)(WW + o + 4);
                const f32x4 b0 = *(const LAS f32x4*)(BV + o), b1 = *(const LAS f32x4*)(BV + o + 4), k0 = *(const LAS f32x4*)(KM + o), k1 = *(const LAS f32x4*)(KM + o + 4);
                const f32x4 r0 = *(const LAS f32x4*)(RR + o), r1 = *(const LAS f32x4*)(RR + o + 4);
                const float vv = VV[t * 64 + v];
                float sa = 0.f;
#pragma unroll
                for (int e = 0; e < 4; ++e) sa += s[e] * a0[e] + s[4 + e] * a1[e];
                sa += __shfl_xor(sa, 1); sa += __shfl_xor(sa, 2); sa += __shfl_xor(sa, 4);
                float oo = 0.f;
#pragma unroll
                for (int e = 0; e < 4; ++e) {
                    s[e] = s[e] * w0[e] + sa * b0[e] + vv * k0[e]; s[4 + e] = s[4 + e] * w1[e] + sa * b1[e] + vv * k1[e];
                    oo += s[e] * r0[e] + s[4 + e] * r1[e];
                }
                oo += __shfl_xor(oo, 1); oo += __shfl_xor(oo, 2); oo += __shfl_xor(oo, 4);
                if (kq == 0) OB[t * 64 + v] = oo;
            }
        }
        __syncthreads();
        {
            const int tok = tid >> 4, jg = tid & 15, v0 = 4 * jg;
            float ov[4], sm = 0.f;
#pragma unroll
            for (int e = 0; e < 4; ++e) { ov[e] = OB[tok * 64 + v0 + e]; sm += ov[e]; }
            sm += __shfl_xor(sm, 1); sm += __shfl_xor(sm, 2); sm += __shfl_xor(sm, 4); sm += __shfl_xor(sm, 8);
            const float mean = sm * (1.f / 64.f); float q = 0.f;
#pragma unroll
            for (int e = 0; e < 4; ++e) { const float dlt = ov[e] - mean; q += dlt * dlt; }
            q += __shfl_xor(q, 1); q += __shfl_xor(q, 2); q += __shfl_xor(q, 4); q += __shfl_xor(q, 8);
            const float rstd = 1.f / sqrtf(q * (1.f / 64.f) + GN_EPS);
            const float bon = BON[tok];
            float res[4];
#pragma unroll
            for (int e = 0; e < 4; ++e) { const int cj = h * 64 + v0 + e;
                const float on = (ov[e] - mean) * rstd * A.in[I_GNG][cj] + A.in[I_GNB][cj];
                res[e] = (on + bon * VV[tok * 64 + v0 + e]) * GG[tok * 64 + v0 + e]; }
            u32x2 w; w.x = pk2(res[0], res[1]); w.y = pk2(res[2], res[3]);
            *(u32x2*)(MIX + (row0 + tok) * DM + 512 + h * 64 + v0) = w;
        }
    }
}

__device__ __forceinline__ float wave_sum(float v) {
#pragma unroll
    for (int o = 1; o < 64; o <<= 1) v += __shfl_xor(v, o);
    return v;
}
__device__ __forceinline__ void ln_rows_phase(const float* in, const float* g, const float* bta, float* outf, bf16_t* outb, int vcu, int G, int tid) {
    const int lane = tid & 63, wave = tid >> 6;
    f32x4 gv[4], bv[4];
#pragma unroll
    for (int j = 0; j < 4; ++j) { gv[j] = *(const f32x4*)(g + 4 * lane + 256 * j); bv[j] = *(const f32x4*)(bta + 4 * lane + 256 * j); }
    for (int m = vcu * NWAVES + wave; m < M; m += G * NWAVES) {
        const f32x4* xr = (const f32x4*)(in + (size_t)m * DM) + lane;
        f32x4 v[4]; float s = 0.f;
#pragma unroll
        for (int j = 0; j < 4; ++j) { v[j] = xr[64 * j]; s += (v[j][0] + v[j][1]) + (v[j][2] + v[j][3]); }
        const float mean = wave_sum(s) * (1.f / DM); float s2 = 0.f;
#pragma unroll
        for (int j = 0; j < 4; ++j) { v[j] = v[j] - mean; s2 += (v[j][0] * v[j][0] + v[j][1] * v[j][1]) + (v[j][2] * v[j][2] + v[j][3] * v[j][3]); }
        const float rstd = 1.f / sqrtf(wave_sum(s2) * (1.f / DM) + LN_EPS);
#pragma unroll
        for (int j = 0; j < 4; ++j) {
            const f32x4 o = v[j] * rstd * gv[j] + bv[j];
            *((f32x4*)(outf + (size_t)m * DM) + lane + 64 * j) = o;
            if (outb) { u32x2 w; w.x = pk2(o[0], o[1]); w.y = pk2(o[2], o[3]); *((u32x2*)(outb + (size_t)m * DM) + lane + 64 * j) = w; }
        }
    }
}

#define GAS __attribute__((address_space(1)))
typedef GAS unsigned gu32;
typedef GAS unsigned long long gu64;
#define RLX_AGENT __ATOMIC_RELAXED, __HIP_MEMORY_SCOPE_AGENT
#define XB_TMO      128
#define XB_XCNT(j)  (256  + 64 * (j))
#define XB_XSUB(j)  (1280 + 64 * (j))
#define XB_XGEN(j)  (2304 + 64 * (j))
#define XB_TOP      3328
#define XB_TOPGEN   3392
#define XCD_BAR_WORDS 3456
#define XB_SPIN_CAP (1u << 18)

__device__ __forceinline__ unsigned xb_ld(unsigned* p)              { return __hip_atomic_load(p, __ATOMIC_RELAXED, __HIP_MEMORY_SCOPE_AGENT); }
__device__ __forceinline__ unsigned xb_add(unsigned* p, unsigned v) { return __hip_atomic_fetch_add(p, v, __ATOMIC_RELAXED, __HIP_MEMORY_SCOPE_AGENT); }
__device__ __forceinline__ unsigned xb_xcc_id() { return (unsigned)__builtin_amdgcn_s_getreg((3 << 11) | 20) & 0xFu; }
#define XB_SPIN(cond, bar) do { unsigned _sp = 0; while (cond) { __builtin_amdgcn_s_sleep(1); \
    if ((++_sp & 255u) == 0u) { if (xb_ld(&(bar)[XB_TMO])) break; if (_sp > XB_SPIN_CAP) { atomicAdd(&(bar)[XB_TMO], 1u); break; } } } } while (0)

struct XcdBarrier {
    unsigned* bar; unsigned x;
    volatile LAS unsigned* st;
};

__device__ __forceinline__ XcdBarrier xcd_barrier_post(unsigned* bar, volatile LAS unsigned* st) {
    XcdBarrier b; b.bar = bar; b.x = xb_xcc_id(); b.st = st;
    if (threadIdx.x == 0) (void)xb_add(&bar[XB_XCNT(b.x)], 1u);
    return b;
}
__device__ __forceinline__ void xcd_barrier_complete(unsigned* bar, unsigned x, unsigned& nloc, unsigned& nx) {
    const unsigned G = gridDim.x * gridDim.y * gridDim.z;
    unsigned sum, cnt, mine, sp = 0u;
    for (;;) {
        sum = 0u; cnt = 0u; mine = 0u;
#pragma unroll
        for (unsigned j = 0; j < 16; ++j) { const unsigned c = xb_ld(&bar[XB_XCNT(j)]); sum += c; cnt += (c > 0u) ? 1u : 0u; mine = (j == x) ? c : mine; }
        if (sum == G) break;
        __builtin_amdgcn_s_sleep(1);
        if ((++sp & 255u) == 0u) { if (xb_ld(&bar[XB_TMO])) break; if (sp > XB_SPIN_CAP) { atomicAdd(&bar[XB_TMO], 1u); break; } }
    }
    nloc = mine > 0u ? mine : 1u; nx = cnt > 0u ? cnt : 1u;
}

__device__ __forceinline__ void xcd_barrier(const XcdBarrier& b) {
    asm volatile("s_waitcnt vmcnt(0)" ::: "memory");
    __syncthreads();
    if (threadIdx.x == 0) {
        unsigned* bar = b.bar;
        __builtin_amdgcn_s_waitcnt(0);
        unsigned nloc = b.st[0], nx = b.st[1];
        if (nloc == 0u) { xcd_barrier_complete(bar, b.x, nloc, nx); b.st[0] = nloc; b.st[1] = nx; }
        const unsigned old = xb_add(&bar[XB_XSUB(b.x)], 1u);
        const unsigned gen = old / nloc;
        if (old + 1u == (gen + 1u) * nloc) {
            __builtin_amdgcn_fence(__ATOMIC_RELEASE, "agent");
            asm volatile("s_waitcnt vmcnt(0)" ::: "memory");
            const unsigned og = xb_add(&bar[XB_TOP], 1u);
            const unsigned tg = og / nx;
            if (og + 1u == (tg + 1u) * nx) xb_add(&bar[XB_TOPGEN], 1u);
            else XB_SPIN(xb_ld(&bar[XB_TOPGEN]) == tg, bar);
            __builtin_amdgcn_fence(__ATOMIC_ACQUIRE, "agent");
            xb_add(&bar[XB_XGEN(b.x)], 1u);
            asm volatile("s_waitcnt vmcnt(0)" ::: "memory");
        } else {
            XB_SPIN(xb_ld(&bar[XB_XGEN(b.x)]) == gen, bar);
            __builtin_amdgcn_fence(__ATOMIC_ACQUIRE, "agent");
            asm volatile("s_waitcnt vmcnt(0)" ::: "memory");
        }
    }
    __syncthreads();
}

constexpr int N_PHASES = 10;
constexpr int MISC_OFF = 143360;
constexpr int CW_BAR = 4096;
constexpr size_t CTL_MEMSET_BYTES = 65536;
#ifndef ONE_LAUNCH
#define ONE_LAUNCH 1
#endif
__global__ void __launch_bounds__(NTHREADS, 2) fwd(Args args) {
    extern __shared__ __attribute__((aligned(16))) unsigned char lds_raw[];
    LAS unsigned char* lds = (LAS unsigned char*)lds_raw;
    const int tid = threadIdx.x, G = gridDim.x, bx = blockIdx.x;
    const int vcu = (G % 8 == 0) ? (bx % 8) * (G / 8) + bx / 8 : bx;
    unsigned char* ws = args.ws;
    bf16_t* Y = (bf16_t*)(ws + WS_Y); bf16_t* MIX = (bf16_t*)(ws + WS_MIX);
    const int lo = args.ph_lo, hi = args.ph_hi;
    volatile LAS unsigned* MISC = (volatile LAS unsigned*)(lds + MISC_OFF);
    if (tid < 32) MISC[tid] = 0u;
    __syncthreads();
    XcdBarrier bar; bar.bar = (unsigned*)(ws + WS_CTL) + CW_BAR; bar.x = 0; bar.st = nullptr;
    if (ONE_LAUNCH) bar = xcd_barrier_post((unsigned*)(ws + WS_CTL) + CW_BAR, MISC + 8);
#define GRID_BAR() do { if (ONE_LAUNCH) xcd_barrier(bar); } while (0)
#ifndef PHMASK
#define PHMASK 0xffff
#endif
#define IN(k) (((PHMASK >> (k)) & 1) && lo <= (k) && (k) < hi)
    if (IN(0)) { p0_prologue(args, lds, vcu, G, tid); GRID_BAR(); }
    if (IN(1)) {
        pg8::Gemm g{(const bf16_t*)(ws + WS_XB), (const bf16_t*)(ws + WS_WIN), M, INC, DM}; pg8::StaticOrder S; S.init(M, INC, G, bx);
        pg8::EpiInProj E{Y, (const float*)(ws + WS_CS), INC, QSCALE};
        pg8::gemm_phase<pg8::EpiInProj, pg8::StaticOrder, true, true>(lds, g, S, E);
        GRID_BAR();
    }
    if (IN(2)) attn_partial_phase(lds, Y, (bf16_t*)(ws + WS_ATTP), (float*)(ws + WS_LSE), vcu, G, tid);
    if (IN(3)) { rwkv_direct_phase(lds, args, Y, MIX, vcu, tid); GRID_BAR(); }
    if (IN(4)) { attn_merge_phase((const bf16_t*)(ws + WS_ATTP), (const float*)(ws + WS_LSE), MIX, vcu, G, tid); GRID_BAR(); }
    if (IN(5)) {
        pg8::Gemm g{MIX, (const bf16_t*)(ws + WS_WOUT), M, DM, DM}; pg8::StaticOrder S; S.init(M, DM, G, bx);
        pg8::EpiResF32 E{args.in[I_X], (float*)(ws + WS_TMP5), DM, ALPHA};
        pg8::gemm_phase<pg8::EpiResF32, pg8::StaticOrder, true, true>(lds, g, S, E);
        GRID_BAR();
    }
    if (IN(6)) { ln_rows_phase((const float*)(ws + WS_TMP5), args.in[I_LN1G], args.in[I_LN1B], args.out, (bf16_t*)(ws + WS_H1B), vcu, G, tid); GRID_BAR(); }
    if (IN(7)) {
        pg8::Gemm g{(const bf16_t*)(ws + WS_H1B), (const bf16_t*)(ws + WS_WGU), M, 2 * FF, DM}; pg8::StaticOrder S; S.init(M, 2 * FF, G, bx);
        pg8::EpiSwiGLU E{(bf16_t*)(ws + WS_HID), FF};
        pg8::gemm_phase<pg8::EpiSwiGLU, pg8::StaticOrder, true, true>(lds, g, S, E);
        GRID_BAR();
    }
    if (IN(8)) {
        pg8::Gemm g{(const bf16_t*)(ws + WS_HID), (const bf16_t*)(ws + WS_WDN), M, DM, FF}; pg8::StaticOrder S; S.init(M, DM, G, bx);
        pg8::EpiResF32 E{args.out, (float*)(ws + WS_TMP7), DM, ALPHA};
        pg8::gemm_phase<pg8::EpiResF32, pg8::StaticOrder, true, true>(lds, g, S, E);
        GRID_BAR();
    }
    if (IN(9)) ln_rows_phase((const float*)(ws + WS_TMP7), args.in[I_LN2G], args.in[I_LN2B], args.out, nullptr, vcu, G, tid);
#undef IN
}

extern "C" void kernel_launch(void* const* d_in, const int* in_sizes, int n_in, void* d_out, int out_size, void* d_ws, size_t ws_size, hipStream_t stream) {
    static int grid = 0;
    if (grid == 0) {
        if (n_in != 22 || out_size != M * DM || ws_size < WS_END) { fprintf(stderr, "kernel_launch: unexpected shapes (n_in %d out %d ws %zu)\n", n_in, out_size, ws_size); grid = -1; return; }
        int dev = 0, cus = 0;
        if (hipGetDevice(&dev) != hipSuccess || hipDeviceGetAttribute(&cus, hipDeviceAttributeMultiprocessorCount, dev) != hipSuccess) { grid = -1; return; }
        if (hipFuncSetAttribute((const void*)fwd, hipFuncAttributeMaxDynamicSharedMemorySize, LDS_BYTES) != hipSuccess) { fprintf(stderr, "kernel_launch: hipFuncSetAttribute failed\n"); grid = -1; return; }
        grid = cus;
    }
    if (grid < 0) return;
    Args a{};
    for (int i = 0; i < 22; ++i) a.in[i] = (const float*)d_in[i];
    a.pos = (const int*)d_in[1]; a.out = (float*)d_out; a.ws = (unsigned char*)d_ws;
    if (ONE_LAUNCH) {
        if (hipMemsetAsync((char*)d_ws + WS_CTL, 0, CTL_MEMSET_BYTES, stream) != hipSuccess) { fprintf(stderr, "kernel_launch: memset failed\n"); return; }
        a.ph_lo = 0; a.ph_hi = N_PHASES;
        hipLaunchKernelGGL(fwd, dim3(grid), dim3(NTHREADS), LDS_BYTES, stream, a);
    } else {
        for (int ph = 0; ph < N_PHASES; ++ph) { a.ph_lo = ph; a.ph_hi = ph + 1; hipLaunchKernelGGL(fwd, dim3(grid), dim3(NTHREADS), LDS_BYTES, stream, a); }
    }
}
```

```cpp
#include <hip/hip_runtime.h>
#include <cstdio>
#include <cstdint>
namespace pg8 {
#define PG8_LAS __attribute__((address_space(3)))
typedef unsigned short bf16_t;
typedef short bf16x8 __attribute__((ext_vector_type(8)));
typedef float f32x4 __attribute__((ext_vector_type(4)));
typedef unsigned u32x4 __attribute__((ext_vector_type(4)));
constexpr int BM = 256, BK = 64, HALF = 128, HTB = HALF * BK * 2  , STAGE_BYTES = 8 * HTB, NXCD = 8, WGM = 8;

__host__ __device__ __forceinline__ int lds_byte(int r, int c) { const int st = (r >> 4) * 2 + (c >> 5), rr = r & 15, cc = c & 31, ob = rr * 64 + cc * 2; return st * 1024 + (ob ^ (((ob >> 9) & 1) << 5)); }
__host__ __device__ __forceinline__ void stage_rc(int b, int& R, int& C) { const int st = b / 1024, sb = b % 1024, swz = sb ^ (((sb >> 9) & 1) << 5); R = (st >> 1) * 16 + swz / 64; C = (st & 1) * 32 + (swz % 64) / 2; }
__host__ __device__ __forceinline__ int perm32(int rho) { const int n = rho >> 4, i = rho & 15; return 8 * (i >> 2) + 4 * n + (i & 3); }

struct Unit { int pm, pn; };
struct Gemm { const bf16_t* A; const bf16_t* Bt; int M, N, K; };

struct StaticOrder {
    int nM, nN, nwg, G, c;
    __host__ __device__ void init(int M, int N, int G_, int c_) { nM = M / BM; nN = N / BM; nwg = nM * nN; G = G_; c = c_; }
    __host__ __device__ bool next(int i, Unit& u) const {
        const long L = (long)i * G + c; if (L >= nwg) return false;
        int wgid = (int)L; { const int q = nwg / NXCD, r = nwg % NXCD, xcd = wgid % NXCD, off = wgid / NXCD; wgid = (xcd < r ? xcd * (q + 1) : r * (q + 1) + (xcd - r) * q) + off; }
        const int nig = WGM * nN, gid = wgid / nig, fm = gid * WGM, gsz = (nM - fm) < WGM ? (nM - fm) : WGM;
        u.pm = fm + ((wgid % nig) % gsz); u.pn = (wgid % nig) / gsz; return true;
    }
    __device__ __forceinline__ void a_ready(const Unit&) const {}
    __device__ __forceinline__ void done(const Unit&) const {}
};


__device__ __forceinline__ unsigned cvt_pk_bf16(float lo, float hi) { unsigned r; asm volatile("v_cvt_pk_bf16_f32 %0, %1, %2" : "=v"(r) : "v"(lo), "v"(hi)); return r; }

struct EpiInProj {
    static constexpr bool PERM = true, AFTER_DRAIN = false;
    bf16_t* Y; const float* cs; int ldc; float qscale;
    __device__ __forceinline__ void operator()(const f32x4 (&acc)[2][2][4][2], const Unit& u, int wr, int wc, int fr, int fq) const {
        const int row0 = u.pm * BM + wr * 64 + fr, col0 = u.pn * BM + wc * 32 + 8 * fq;
        const bool rope = (u.pn < 4) && ((wc & 1) == 0);
        const float qs = (u.pn < 2) ? qscale : 1.f;
        const float sg = (fq == 0) ? -1.f : 1.f;
#pragma unroll
        for (int ai = 0; ai < 2; ++ai)
#pragma unroll
            for (int m = 0; m < 4; ++m) {
                const int row = row0 + ai * HALF + m * 16;
                bf16_t* rowp = Y + (size_t)row * ldc + col0;
                f32x4 c0 = {1.f, 1.f, 1.f, 1.f}, c1 = c0, s0 = {0.f, 0.f, 0.f, 0.f}, s1 = s0;
                if (rope) { const f32x4* cp = (const f32x4*)(cs + (size_t)row * 16); c0 = cp[0]; c1 = cp[1]; s0 = cp[2]; s1 = cp[3]; }
#pragma unroll
                for (int bj = 0; bj < 2; ++bj) {
                    f32x4 v0 = acc[ai][bj][m][0], v1 = acc[ai][bj][m][1];
                    if (rope) {
                        f32x4 o0, o1;
#pragma unroll
                        for (int e = 0; e < 4; ++e) { o0[e] = __shfl_xor(v0[e], 16); o1[e] = __shfl_xor(v1[e], 16); }
                        const f32x4 r0 = v0 * c0 + (o0 * s0) * sg, r1 = v1 * c1 + (o1 * s1) * sg;
                        if (fq < 2) { v0 = r0; v1 = r1; }
                    }
                    v0 = v0 * qs; v1 = v1 * qs;
                    u32x4 w; w.x = cvt_pk_bf16(v0[0], v0[1]); w.y = cvt_pk_bf16(v0[2], v0[3]); w.z = cvt_pk_bf16(v1[0], v1[1]); w.w = cvt_pk_bf16(v1[2], v1[3]);
                    *(u32x4*)(rowp + bj * HALF) = w;
                }
            }
    }
};

struct EpiSwiGLU {
    static constexpr bool PERM = true, AFTER_DRAIN = false;
    bf16_t* H; int ldc;
    __device__ __forceinline__ void operator()(const f32x4 (&acc)[2][2][4][2], const Unit& u, int wr, int wc, int fr, int fq) const {
        const int row0 = u.pm * BM + wr * 64 + fr, col0 = u.pn * HALF + wc * 32 + 8 * fq;
#pragma unroll
        for (int ai = 0; ai < 2; ++ai)
#pragma unroll
            for (int m = 0; m < 4; ++m) {
                bf16_t* rowp = H + (size_t)(row0 + ai * HALF + m * 16) * ldc + col0;
                float h[8];
#pragma unroll
                for (int n = 0; n < 2; ++n)
#pragma unroll
                    for (int e = 0; e < 4; ++e) { const float g = acc[ai][0][m][n][e], up = acc[ai][1][m][n][e];
                        const float sig = __builtin_amdgcn_rcpf(1.f + __builtin_amdgcn_exp2f(-1.4426950408889634f * g)); h[n * 4 + e] = g * sig * up; }
                u32x4 w; w.x = cvt_pk_bf16(h[0], h[1]); w.y = cvt_pk_bf16(h[2], h[3]); w.z = cvt_pk_bf16(h[4], h[5]); w.w = cvt_pk_bf16(h[6], h[7]);
                *(u32x4*)rowp = w;
            }
    }
};

struct EpiResF32 {
    static constexpr bool PERM = false, AFTER_DRAIN = false;
    const float* base; float* out; int ldc; float alpha;
    __device__ __forceinline__ void operator()(const f32x4 (&acc)[2][2][4][2], const Unit& u, int wr, int wc, int fr, int fq) const {
        const int row0 = u.pm * BM + wr * 64 + fr, col0 = u.pn * BM + wc * 32 + 4 * fq;
#pragma unroll
        for (int ai = 0; ai < 2; ++ai)
#pragma unroll
            for (int m = 0; m < 4; ++m) { const size_t off = (size_t)(row0 + ai * HALF + m * 16) * ldc + col0;
#pragma unroll
                for (int bj = 0; bj < 2; ++bj)
#pragma unroll
                    for (int n = 0; n < 2; ++n) { const f32x4 bs = *(const f32x4*)(base + off + bj * HALF + n * 16); *(f32x4*)(out + off + bj * HALF + n * 16) = bs * alpha + acc[ai][bj][m][n]; } }
    }
};

template <class Epi, class Sched, bool ALIGN_EPI = false, bool SP2 = false>
__device__ __forceinline__ void gemm_phase(PG8_LAS unsigned char* lds, const Gemm g, const Sched& S, const Epi& E) {
    const int tid = threadIdx.x, wid = __builtin_amdgcn_readfirstlane(tid >> 6), lane = tid & 63, wr = wid >> 2, wc = wid & 3, fr = lane & 15, fq = lane >> 4;
    const int K = g.K, nt = K / BK;
    unsigned voffA[2], voffB[2];
#pragma unroll
    for (int i = 0; i < 2; ++i) { int R, C; stage_rc(tid * 16 + i * 8192, R, C); const int Rb = Epi::PERM ? ((R & ~31) + perm32(R & 31)) : R;
        voffA[i] = (unsigned)(R * K + C) * 2u; voffB[i] = (unsigned)(Rb * K + C) * 2u; }
    const size_t kstep = (size_t)(BK * 2);
    const size_t hstep = (size_t)HALF * K * 2;
    const size_t tstep = 2 * hstep;
    const unsigned ldsw = (unsigned)wid * 1024u;
    const int aoff = lds_byte(wr * 64 + fr, fq * 8), boff = lds_byte(wc * 32 + fr, fq * 8);
#define PG8_SA(b, h) (((b) * 2 + (h)) * HTB)
#define PG8_SB(b, h) ((4 + (b) * 2 + (h)) * HTB)
#define PG8_STAGE(bufoff, gbase, voff) do { _Pragma("unroll") for (int _i = 0; _i < 2; ++_i) \
        __builtin_amdgcn_global_load_lds((const unsigned*)((const char*)(gbase) + (voff)[_i]), (PG8_LAS unsigned*)(lds + (bufoff) + ldsw + _i * 8192), 16, 0, 0); } while (0)
#define PG8_LDA(dst, b, h) do { _Pragma("unroll") for (int m = 0; m < 4; ++m) _Pragma("unroll") for (int k = 0; k < 2; ++k) dst[m][k] = *(const PG8_LAS bf16x8*)(lds + PG8_SA(b, h) + aoff + m * 2048 + k * 1024); } while (0)
#define PG8_LDB(dst, b, h) do { _Pragma("unroll") for (int n = 0; n < 2; ++n) _Pragma("unroll") for (int k = 0; k < 2; ++k) dst[n][k] = *(const PG8_LAS bf16x8*)(lds + PG8_SB(b, h) + boff + n * 2048 + k * 1024); } while (0)
#define PG8_MMA(ai, bj, At, Bt) do { __builtin_amdgcn_s_setprio(1); _Pragma("unroll") for (int m = 0; m < 4; ++m) _Pragma("unroll") for (int n = 0; n < 2; ++n) _Pragma("unroll") for (int k = 0; k < 2; ++k) \
        acc[ai][bj][m][n] = __builtin_amdgcn_mfma_f32_16x16x32_bf16(Bt[n][k], At[m][k], acc[ai][bj][m][n], 0, 0, 0); __builtin_amdgcn_s_setprio(0); } while (0)
#define PG8_WAIT_V(n) asm volatile("s_waitcnt vmcnt(" #n ")" ::: "memory")
#define PG8_WAIT_L(n) asm volatile("s_waitcnt lgkmcnt(" #n ")" ::: "memory")
#define PG8_BAR __builtin_amdgcn_s_barrier()
#define PG8_SCHED __builtin_amdgcn_sched_barrier(0)
    Unit cur, nxt; int ui = 0;
    if (!S.next(0, cur)) return;
    f32x4 acc[2][2][4][2];
#pragma unroll
    for (int a = 0; a < 2; ++a)
#pragma unroll
        for (int b = 0; b < 2; ++b)
#pragma unroll
            for (int m = 0; m < 4; ++m)
#pragma unroll
                for (int n = 0; n < 2; ++n) acc[a][b][m][n] = (f32x4){0.f, 0.f, 0.f, 0.f};
    bf16x8 At[4][2], B0[2][2], B1[2][2];
    const char* cA = (const char*)g.A + (size_t)cur.pm * tstep; const char* cB = (const char*)g.Bt + (size_t)cur.pn * tstep;
    S.a_ready(cur);
    if constexpr (SP2) {
        PG8_STAGE(PG8_SB(0, 0), cB, voffB); PG8_STAGE(PG8_SB(0, 1), cB + hstep, voffB); PG8_STAGE(PG8_SA(0, 0), cA, voffA); PG8_STAGE(PG8_SA(0, 1), cA + hstep, voffA);
        if (wr == 1) PG8_BAR;
        PG8_WAIT_V(2); PG8_BAR;
        PG8_STAGE(PG8_SB(1, 0), cB + kstep, voffB); PG8_STAGE(PG8_SA(1, 0), cA + kstep, voffA); PG8_STAGE(PG8_SB(1, 1), cB + hstep + kstep, voffB);
        PG8_WAIT_V(6); PG8_BAR;
    } else {
        PG8_STAGE(PG8_SB(0, 0), cB, voffB); PG8_STAGE(PG8_SA(0, 0), cA, voffA); PG8_STAGE(PG8_SB(0, 1), cB + hstep, voffB); PG8_STAGE(PG8_SA(0, 1), cA + hstep, voffA);
        if (wr == 1) PG8_BAR;
        PG8_WAIT_V(4); PG8_BAR;
        PG8_STAGE(PG8_SB(1, 0), cB + kstep, voffB); PG8_STAGE(PG8_SA(1, 0), cA + kstep, voffA); PG8_STAGE(PG8_SB(1, 1), cB + hstep + kstep, voffB);
        PG8_WAIT_V(6); PG8_BAR;
    }
    for (;;) {
        const bool has_next = S.next(ui + 1, nxt);
        const char* nA = has_next ? (const char*)g.A + (size_t)nxt.pm * tstep : cA; const char* nB = has_next ? (const char*)g.Bt + (size_t)nxt.pn * tstep : cB;
        for (int t = 0; t < nt; t += 2) {
            const bool last = (t == nt - 2);
            const char* a1 = cA + (size_t)(t + 1) * kstep;
            const char* a2 = last ? nA : cA + (size_t)(t + 2) * kstep; const char* b2 = last ? nB : cB + (size_t)(t + 2) * kstep;
            const char* a3 = a2 + kstep; const char* b3 = b2 + kstep;
            if (last && has_next) S.a_ready(nxt);
            if constexpr (SP2) {
            PG8_LDB(B0, 0, 0); PG8_LDB(B1, 0, 1); PG8_SCHED; PG8_LDA(At, 0, 0); PG8_STAGE(PG8_SA(1, 1), a1 + hstep, voffA);
            PG8_WAIT_V(8); PG8_WAIT_L(0); PG8_BAR; PG8_MMA(0, 0, At, B0); PG8_MMA(0, 1, At, B1); PG8_BAR; PG8_SCHED;
            PG8_LDA(At, 0, 1); PG8_STAGE(PG8_SB(0, 0), b2, voffB); PG8_STAGE(PG8_SB(0, 1), b2 + hstep, voffB); PG8_STAGE(PG8_SA(0, 0), a2, voffA);
            PG8_WAIT_V(8); PG8_WAIT_L(0); PG8_BAR; PG8_MMA(1, 0, At, B0); PG8_MMA(1, 1, At, B1); PG8_BAR; PG8_SCHED;
            PG8_LDB(B0, 1, 0); PG8_LDB(B1, 1, 1); PG8_SCHED; PG8_LDA(At, 1, 0); PG8_STAGE(PG8_SA(0, 1), a2 + hstep, voffA);
            PG8_WAIT_V(8); PG8_WAIT_L(0); PG8_BAR; PG8_MMA(0, 0, At, B0); PG8_MMA(0, 1, At, B1); PG8_BAR; PG8_SCHED;
            PG8_LDA(At, 1, 1); PG8_STAGE(PG8_SB(1, 0), b3, voffB); PG8_STAGE(PG8_SB(1, 1), b3 + hstep, voffB); PG8_STAGE(PG8_SA(1, 0), a3, voffA);
            PG8_WAIT_V(8); PG8_WAIT_L(0); PG8_BAR; PG8_MMA(1, 0, At, B0); PG8_MMA(1, 1, At, B1); PG8_BAR; PG8_SCHED;
            } else {
            PG8_LDB(B0, 0, 0); PG8_SCHED; PG8_LDA(At, 0, 0); PG8_STAGE(PG8_SA(1, 1), a1 + hstep, voffA);
            PG8_WAIT_L(8); PG8_BAR; PG8_WAIT_L(0); PG8_MMA(0, 0, At, B0); PG8_BAR; PG8_SCHED;
            PG8_LDB(B1, 0, 1); PG8_STAGE(PG8_SB(0, 0), b2, voffB);
            PG8_BAR; PG8_WAIT_L(0); PG8_MMA(0, 1, At, B1); PG8_BAR;
            PG8_LDA(At, 0, 1); PG8_STAGE(PG8_SA(0, 0), a2, voffA);
            PG8_BAR; PG8_WAIT_L(0); PG8_MMA(1, 0, At, B0); PG8_BAR; PG8_SCHED;
            PG8_STAGE(PG8_SB(0, 1), b2 + hstep, voffB);
            PG8_WAIT_V(6); PG8_BAR; PG8_MMA(1, 1, At, B1); PG8_BAR;
            PG8_LDB(B0, 1, 0); PG8_SCHED; PG8_LDA(At, 1, 0); PG8_STAGE(PG8_SA(0, 1), a2 + hstep, voffA);
            PG8_WAIT_L(8); PG8_BAR; PG8_WAIT_L(0); PG8_MMA(0, 0, At, B0); PG8_BAR; PG8_SCHED;
            PG8_LDB(B1, 1, 1); PG8_STAGE(PG8_SB(1, 0), b3, voffB);
            PG8_BAR; PG8_WAIT_L(0); PG8_MMA(0, 1, At, B1); PG8_BAR;
            PG8_LDA(At, 1, 1); PG8_STAGE(PG8_SA(1, 0), a3, voffA);
            PG8_BAR; PG8_WAIT_L(0); PG8_MMA(1, 0, At, B0); PG8_BAR; PG8_SCHED;
            PG8_STAGE(PG8_SB(1, 1), b3 + hstep, voffB);
            PG8_WAIT_V(6); PG8_BAR; PG8_MMA(1, 1, At, B1); PG8_BAR;
            }
        }
        if constexpr (ALIGN_EPI) { if (wr == 0) PG8_BAR; }
        if constexpr (!Epi::AFTER_DRAIN) { E(acc, cur, wr, wc, fr, fq); S.done(cur); }
        if (!has_next) break;
#pragma unroll
        for (int a = 0; a < 2; ++a)
#pragma unroll
            for (int b = 0; b < 2; ++b)
#pragma unroll
                for (int m = 0; m < 4; ++m)
#pragma unroll
                    for (int n = 0; n < 2; ++n) acc[a][b][m][n] = (f32x4){0.f, 0.f, 0.f, 0.f};
        cur = nxt; cA = nA; cB = nB; ++ui;
        if constexpr (ALIGN_EPI) { if (wr == 1) PG8_BAR; }
    }
    PG8_WAIT_V(0);
    if constexpr (!ALIGN_EPI) { if (wr == 0) PG8_BAR; }
    PG8_BAR;
    if constexpr (Epi::AFTER_DRAIN) { E.fused(acc, cur, wr, wc, fr, fq, lds, wid, lane); S.done(cur); }
#undef PG8_SA
#undef PG8_SB
#undef PG8_STAGE
#undef PG8_LDA
#undef PG8_LDB
#undef PG8_MMA
#undef PG8_WAIT_V
#undef PG8_WAIT_L
#undef PG8_BAR
#undef PG8_SCHED
}
}

#define LAS __attribute__((address_space(3)))
typedef unsigned short bf16_t;
typedef short bf16x8 __attribute__((ext_vector_type(8)));
typedef short s16x4 __attribute__((ext_vector_type(4)));
typedef float f32x4 __attribute__((ext_vector_type(4)));
typedef float f32x16 __attribute__((ext_vector_type(16)));
typedef unsigned u32x2 __attribute__((ext_vector_type(2)));
typedef unsigned u32x4 __attribute__((ext_vector_type(4)));

constexpr int NB = 4, SEQ = 8192, DM = 1024, M = NB * SEQ, INC = 3328, FF = 2816, NH = 8, HD = 64;
constexpr int C_Q = 0, C_K = 512, C_V = 1024, C_RW = 1536, C_R = 1536, C_KR = 2048, C_VR = 2560, C_DW = 3072, C_DA = 3136, C_DG = 3200;
constexpr float ALPHA = 1.189207115002721f;
constexpr float LN_EPS = 1e-5f, GN_EPS = 64e-5f, L2_EPS = 1e-6f;
constexpr float DECAY_SCALE = 0.6065306597126334f;
constexpr float LOG2E = 1.4426950408889634f;
constexpr float QSCALE = 0.125f * LOG2E;
constexpr int NWAVES = 8, NTHREADS = 512;

constexpr size_t MiB = 1u << 20;
constexpr size_t WS_CTL = 0, CTL_ZERO_BYTES = 1 * MiB;
constexpr size_t WS_WIN = 1 * MiB, WS_WOUT = 8 * MiB, WS_WGU = 10 * MiB, WS_WDN = 21 * MiB, WS_CS = 28 * MiB;
constexpr size_t WS_Y = 32 * MiB;
constexpr size_t WS_HID = 32 * MiB;
constexpr size_t WS_TMP5 = 32 * MiB;
constexpr size_t WS_XB = 240 * MiB;
constexpr size_t WS_ATTP = 240 * MiB;
constexpr size_t WS_TMP7 = 240 * MiB;
constexpr size_t WS_LSE = 336 * MiB;
constexpr size_t WS_MIX = 340 * MiB;
constexpr size_t WS_H1B = 404 * MiB;
constexpr size_t WS_END = 468 * MiB;

constexpr int LDS_BYTES = 147456;

__device__ __forceinline__ unsigned f2bf(float f) { unsigned u = __builtin_bit_cast(unsigned, f); return (u + 0x7fffu + ((u >> 16) & 1u)) >> 16; }
__device__ __forceinline__ unsigned pk2(float lo, float hi) { return f2bf(lo) | (f2bf(hi) << 16); }
__device__ __forceinline__ float bf2f(unsigned b) { return __builtin_bit_cast(float, b << 16); }
__device__ __forceinline__ float sigmoidf_(float x) { return 1.f / (1.f + __expf(-x)); }
#define LDS_WAIT() asm volatile("s_waitcnt lgkmcnt(0)" ::: "memory")

struct Args {
    const float* in[22]; const int* pos; float* out; unsigned char* ws; int ph_lo, ph_hi, pad0, pad1;
};
enum { I_X = 0, I_POS = 1, I_WIN = 2, I_WOUT = 3, I_MU = 4, I_W0 = 5, I_WD = 6, I_A0 = 7, I_WA = 8, I_WG = 9, I_KK = 10, I_KA = 11, I_RK = 12, I_GNG = 13, I_GNB = 14,
       I_LN1G = 15, I_LN1B = 16, I_FG = 17, I_FU = 18, I_FD = 19, I_LN2G = 20, I_LN2B = 21 };

__device__ __forceinline__ void p0_transpose_item(const float* W, int K, int N, bf16_t* WT, int dst_row0, LAS float* scr, int k0, int n0, int lane) {
#pragma unroll 8
    for (int i = 0; i < 32; ++i) { const int kk = 2 * i + (lane >> 5); scr[kk * 33 + (lane & 31)] = W[(size_t)(k0 + kk) * N + n0 + (lane & 31)]; }
    LDS_WAIT();
    const int c = lane & 7;
#pragma unroll
    for (int j = 0; j < 4; ++j) { const int n = (lane >> 3) + 8 * j; const LAS float* s = scr + (8 * c) * 33 + n;
        u32x4 o; o.x = pk2(s[0 * 33], s[1 * 33]); o.y = pk2(s[2 * 33], s[3 * 33]); o.z = pk2(s[4 * 33], s[5 * 33]); o.w = pk2(s[6 * 33], s[7 * 33]);
        *(u32x4*)(WT + (size_t)(dst_row0 + n) * K + k0 + 8 * c) = o; }
    LDS_WAIT();
}

__device__ __forceinline__ void sincos_rev(float angf, float& c, float& s) {
    const double a = (double)angf;
    double r = a * 0.15915494309189535; r = r - floor(r); if (r >= 0.5) r -= 1.0;
    const double x = r * 6.283185307179586, x2 = x * x;
    double sc = 1.0, ss = 1.0;
    sc = 1.0; ss = 1.0;
#pragma unroll
    for (int k = 13; k >= 1; --k) { sc = 1.0 - sc * x2 * (1.0 / (double)((2 * k - 1) * (2 * k))); ss = 1.0 - ss * x2 * (1.0 / (double)((2 * k) * (2 * k + 1))); }
    c = (float)sc; s = (float)(ss * x);
}

__device__ __forceinline__ void p0_prologue(const Args& A, LAS unsigned char* lds, int vcu, int G, int tid) {
    const int lane = tid & 63, wave = tid >> 6;
    unsigned char* ws = A.ws;
    LAS float* scr = (LAS float*)(lds + wave * 16384);
    const int gw = vcu * NWAVES + wave, NGW = G * NWAVES;
    constexpr int I_IN = (DM / 64) * (INC / 32), I_OUT = (DM / 64) * (DM / 32), I_G = (DM / 64) * (FF / 32), I_D = (FF / 64) * (DM / 32);
    constexpr int NITEMS = I_IN + I_OUT + 2 * I_G + I_D;
    for (int it = gw; it < NITEMS; it += NGW) {
        int r = it;
        if (r < I_IN) { const int nb = INC / 32, kb = r / nb, n0 = 32 * (r % nb); p0_transpose_item(A.in[I_WIN], DM, INC, (bf16_t*)(ws + WS_WIN), n0, scr, 64 * kb, n0, lane); continue; } r -= I_IN;
        if (r < I_OUT) { const int nb = DM / 32, kb = r / nb, n0 = 32 * (r % nb); p0_transpose_item(A.in[I_WOUT], DM, DM, (bf16_t*)(ws + WS_WOUT), n0, scr, 64 * kb, n0, lane); continue; } r -= I_OUT;
        if (r < 2 * I_G) { const int up = r >= I_G; if (up) r -= I_G; const int nb = FF / 32, kb = r / nb, n0 = 32 * (r % nb);
            p0_transpose_item(A.in[up ? I_FU : I_FG], DM, FF, (bf16_t*)(ws + WS_WGU), 256 * (n0 / 128) + (n0 % 128) + (up ? 128 : 0), scr, 64 * kb, n0, lane); continue; } r -= 2 * I_G;
        { const int nb = DM / 32, kb = r / nb, n0 = 32 * (r % nb); p0_transpose_item(A.in[I_FD], FF, DM, (bf16_t*)(ws + WS_WDN), n0, scr, 64 * kb, n0, lane); }
    }
    { const float* x = A.in[I_X]; bf16_t* xb = (bf16_t*)(ws + WS_XB);
      const size_t n8 = (size_t)M * DM / 8;
      for (size_t i = (size_t)vcu * NTHREADS + tid; i < n8; i += (size_t)G * NTHREADS) {
          const f32x4 a = *(const f32x4*)(x + i * 8), b = *(const f32x4*)(x + i * 8 + 4);
          u32x4 o; o.x = pk2(a[0], a[1]); o.y = pk2(a[2], a[3]); o.z = pk2(b[0], b[1]); o.w = pk2(b[2], b[3]);
          *(u32x4*)(xb + i * 8) = o; } }
    { float* cs = (float*)(ws + WS_CS);
      for (int i = vcu * NTHREADS + tid; i < M * 8; i += G * NTHREADS) {
          const int m = i >> 3, f = i & 7;
          const float invf[8] = {1.0f, 0.1939227432012558f, 0.03760603070259094f, 0.007292664609849453f, 0.0014142135623842478f, 0.00027424818836152554f, 5.318296098266728e-05f, 1.0313386155758053e-05f};
          float fr = invf[0];
#pragma unroll
          for (int q = 1; q < 8; ++q) fr = (f == q) ? invf[q] : fr;
          const float ang = (float)A.pos[m] * fr;
          float c, s; sincos_rev(ang, c, s);
          cs[(size_t)m * 16 + f] = c; cs[(size_t)m * 16 + 8 + f] = s; } }
}

__device__ __forceinline__ int crow(int r, int hi) { return (r & 3) + 8 * (r >> 2) + 4 * hi; }
typedef short v4i16_t __attribute__((ext_vector_type(4)));
__device__ __forceinline__ s16x4 vtr(const LAS unsigned char* p) { return __builtin_bit_cast(s16x4, __builtin_amdgcn_ds_read_tr16_b64_v4i16((LAS v4i16_t*)p)); }

constexpr int ATT_KROWS = 384;
constexpr int ATT_LK = 0, ATT_LV = ATT_KROWS * 128, ATT_LW = 2 * ATT_KROWS * 128, ATT_WSCR = 4096 + 256;

__device__ __forceinline__ void attn_partial_phase(LAS unsigned char* lds, const bf16_t* Y, bf16_t* OP, float* LSE, int vcu, int G, int tid) {
    const int lane = tid & 63, wid = __builtin_amdgcn_readfirstlane(tid >> 6), r32 = lane & 31, hi = lane >> 5;
    LAS unsigned char* Kimg = lds + ATT_LK; LAS unsigned char* Vimg = lds + ATT_LV;
    LAS unsigned char* wscr = lds + ATT_LW + wid * ATT_WSCR;
    LAS float* wsf = (LAS float*)(wscr + 4096);
    for (int unit = vcu; unit < 32 * 96; unit += G) {
        const int bh = unit / 96, rem = unit % 96, p = rem >> 5, j = rem & 31;
        const int b = bh >> 3, h = bh & 7;
        const int dl = 2 * p, d = 1 << dl;
        const int nblk = 32 >> dl;
        const int rcls = j / nblk, i0 = (j % nblk) * 256;
        const size_t rowb = (size_t)b * SEQ;
        for (int idx = tid; idx < ATT_KROWS * 8; idx += NTHREADS) {
            const int row = idx >> 3, ch = idx & 7, ci = i0 - 128 + row;
            u32x4 kv = {0u, 0u, 0u, 0u}, vv = kv;
            if (ci >= 0) { const bf16_t* pp = Y + (rowb + (size_t)ci * d + rcls) * INC + h * HD + ch * 8; kv = *(const u32x4*)(pp + C_K); vv = *(const u32x4*)(pp + C_V); }
            *(LAS u32x4*)(Kimg + row * 128 + ((ch ^ ((row >> 1) & 7)) << 4)) = kv;
            *(LAS u32x4*)(Vimg + row * 128 + ((ch ^ (((row >> 1) & 1) << 2)) << 4)) = vv;
        }
        __syncthreads();
        const int qidx = i0 + 32 * wid + r32;
        const bf16_t* qptr = Y + (rowb + (size_t)qidx * d + rcls) * INC + C_Q + h * HD;
        bf16x8 qf[4];
#pragma unroll
        for (int d0 = 0; d0 < 4; ++d0) qf[d0] = *(const bf16x8*)(qptr + 16 * d0 + 8 * hi);
        f32x16 pt[5];
#pragma unroll
        for (int kt = 0; kt < 5; ++kt) {
            f32x16 acc = {};
            const int row = 32 * wid + 32 * kt + r32;
#pragma unroll
            for (int d0 = 0; d0 < 4; ++d0) {
                const int ch = 2 * d0 + hi;
                const bf16x8 kf = *(const LAS bf16x8*)(Kimg + row * 128 + ((ch ^ ((row >> 1) & 7)) << 4));
                acc = __builtin_amdgcn_mfma_f32_32x32x16_bf16(kf, qf[d0], acc, 0, 0, 0);
            }
            pt[kt] = acc;
        }
        float mx = -INFINITY;
#pragma unroll
        for (int kt = 0; kt < 5; ++kt)
#pragma unroll
            for (int r = 0; r < 16; ++r) {
                const int cr = crow(r, hi);
                const int delta = 128 - 32 * kt + r32 - cr;
                const int kidx = i0 - 128 + 32 * wid + 32 * kt + cr;
                const bool valid = (delta >= 0) && (delta <= 128) && (kidx >= 0);
                float v = pt[kt][r]; v = valid ? v : -INFINITY; pt[kt][r] = v; mx = fmaxf(mx, v);
            }
        mx = fmaxf(mx, __shfl_xor(mx, 32));
        float l = 0.f;
#pragma unroll
        for (int kt = 0; kt < 5; ++kt)
#pragma unroll
            for (int r = 0; r < 16; ++r) { const float e = __builtin_amdgcn_exp2f(pt[kt][r] - mx); pt[kt][r] = e; l += e; }
        l += __shfl_xor(l, 32);
        f32x16 o[2]; o[0] = f32x16{}; o[1] = f32x16{};
        const int g1 = (lane >> 4) & 1, q4 = (lane & 15) >> 2, p4 = lane & 3;
#pragma unroll
        for (int kt = 0; kt < 5; ++kt)
#pragma unroll
            for (int s = 0; s < 2; ++s) {
                u32x4 pw;
                pw.x = pk2(pt[kt][8 * s + 0], pt[kt][8 * s + 1]); pw.y = pk2(pt[kt][8 * s + 2], pt[kt][8 * s + 3]);
                pw.z = pk2(pt[kt][8 * s + 4], pt[kt][8 * s + 5]); pw.w = pk2(pt[kt][8 * s + 6], pt[kt][8 * s + 7]);
                const bf16x8 pa = __builtin_bit_cast(bf16x8, pw);
                const int rlo = 32 * wid + 32 * kt + 16 * s + 4 * hi + q4, rhi = rlo + 8;
#pragma unroll
                for (int dh = 0; dh < 2; ++dh) {
                    const int chunk = 4 * dh + 2 * g1 + (p4 >> 1), sub = 8 * (p4 & 1);
                    const s16x4 vlo = vtr(Vimg + rlo * 128 + ((chunk ^ (((rlo >> 1) & 1) << 2)) << 4) + sub);
                    const s16x4 vhi = vtr(Vimg + rhi * 128 + ((chunk ^ (((rhi >> 1) & 1) << 2)) << 4) + sub);
                    const bf16x8 vf = (bf16x8){vlo[0], vlo[1], vlo[2], vlo[3], vhi[0], vhi[1], vhi[2], vhi[3]};
                    o[dh] = __builtin_amdgcn_mfma_f32_32x32x16_bf16(pa, vf, o[dh], 0, 0, 0);
                }
            }
        if (hi == 0) wsf[r32] = l;
        LDS_WAIT();
        bf16_t LAS* stg = (bf16_t LAS*)wscr;
#pragma unroll
        for (int r = 0; r < 16; ++r) {
            const int q = crow(r, hi); const float rl = 1.f / wsf[q];
            stg[q * 64 + r32] = (bf16_t)f2bf(o[0][r] * rl); stg[q * 64 + 32 + r32] = (bf16_t)f2bf(o[1][r] * rl);
        }
        LDS_WAIT();
        bf16_t* OPp = OP + (size_t)p * M * 512;
#pragma unroll
        for (int i = 0; i < 4; ++i) {
            const int q = i * 8 + (lane >> 3), ch = lane & 7;
            const u32x4 v = *(const LAS u32x4*)(wscr + q * 128 + ch * 16);
            const size_t tok = rowb + (size_t)(i0 + 32 * wid + q) * d + rcls;
            *(u32x4*)(OPp + tok * 512 + h * HD + ch * 8) = v;
        }
        if (hi == 0) { const size_t tok = rowb + (size_t)qidx * d + rcls; LSE[(size_t)p * M * 8 + tok * 8 + h] = mx + __log2f(l); }
        __syncthreads();
    }
}

__device__ __forceinline__ void attn_merge_phase(const bf16_t* OP, const float* LSE, bf16_t* MIX, int vcu, int G, int tid) {
    const size_t total = (size_t)M * 64;
    for (size_t i = (size_t)vcu * NTHREADS + tid; i < total; i += (size_t)G * NTHREADS) {
        const size_t tok = i >> 6; const int hc = (int)(i & 63), h = hc >> 3;
        const float l0 = LSE[tok * 8 + h], l1 = LSE[(size_t)M * 8 + tok * 8 + h], l2 = LSE[(size_t)2 * M * 8 + tok * 8 + h];
        const float mx = fmaxf(l0, fmaxf(l1, l2));
        float w0 = __builtin_amdgcn_exp2f(l0 - mx), w1 = __builtin_amdgcn_exp2f(l1 - mx), w2 = __builtin_amdgcn_exp2f(l2 - mx);
        const float inv = 1.f / (w0 + w1 + w2); w0 *= inv; w1 *= inv; w2 *= inv;
        const u32x4 a = *(const u32x4*)(OP + tok * 512 + hc * 8), bq = *(const u32x4*)(OP + (size_t)M * 512 + tok * 512 + hc * 8), c = *(const u32x4*)(OP + (size_t)2 * M * 512 + tok * 512 + hc * 8);
        u32x4 o;
#pragma unroll
        for (int e = 0; e < 4; ++e) {
            const float lo = w0 * bf2f(a[e] & 0xffffu) + w1 * bf2f(bq[e] & 0xffffu) + w2 * bf2f(c[e] & 0xffffu);
            const float hi = w0 * bf2f(a[e] >> 16) + w1 * bf2f(bq[e] >> 16) + w2 * bf2f(c[e] >> 16);
            o[e] = pk2(lo, hi);
        }
        *(u32x4*)(MIX + tok * DM + hc * 8) = o;
    }
}

__device__ __forceinline__ float ysh(const bf16_t* Y, size_t row, int t, int col, const float* mu) {
    const float yc = bf2f(Y[row * INC + col]); const float yp = (t > 0) ? bf2f(Y[(row - 1) * INC + col]) : 0.f;
    return yc + mu[col - C_RW] * (yp - yc);
}
__device__ __forceinline__ void rwkv_direct_phase(LAS unsigned char* lds, const Args& A, const bf16_t* Y, bf16_t* MIX, int vcu, int tid) {
    if (vcu >= 32) return;
    const int b = vcu >> 3, h = vcu & 7;
    LAS float* LIN = (LAS float*)lds;
    LAS float* RR = LIN + 32 * 256;
    LAS float* WW = RR + 2048; LAS float* KM = WW + 2048; LAS float* VV = KM + 2048; LAS float* AV = VV + 2048; LAS float* BV = AV + 2048; LAS float* GG = BV + 2048; LAS float* OB = GG + 2048;
    LAS float* BON = OB + 2048;
    const float* mu = A.in[I_MU];
    float s[8];
#pragma unroll
    for (int i = 0; i < 8; ++i) s[i] = 0.f;
#pragma unroll 1
    for (int ci = 0; ci < SEQ / 32; ++ci) {
        const int t0 = ci * 32; const size_t row0 = (size_t)b * SEQ + t0;
        for (int idx = tid; idx < 32 * 256; idx += NTHREADS) {
            const int tok = idx >> 8, c = idx & 255;
            float v = ysh(Y, row0 + tok, t0 + tok, C_DW + c, mu);
            if (c < 64) v = tanhf(v); else if (c >= 128) v = sigmoidf_(v);
            LIN[idx] = v;
        }
        __syncthreads();
        {
            const int tok = tid >> 4, jg = tid & 15, j0 = 4 * jg, cj = h * 64 + j0;
            float wl[4], al[4], gl[4];
#pragma unroll
            for (int e = 0; e < 4; ++e) { wl[e] = A.in[I_W0][cj + e]; al[e] = A.in[I_A0][cj + e]; gl[e] = 0.f; }
            const LAS float* li = LIN + tok * 256;
#pragma unroll 2
            for (int i = 0; i < 64; ++i) {
                const f32x4 wd = *(const f32x4*)(A.in[I_WD] + (size_t)i * 512 + cj), wa = *(const f32x4*)(A.in[I_WA] + (size_t)i * 512 + cj);
                const float x1 = li[i], x2 = li[64 + i];
#pragma unroll
                for (int e = 0; e < 4; ++e) { wl[e] += x1 * wd[e]; al[e] += x2 * wa[e]; }
            }
#pragma unroll 2
            for (int i = 0; i < 128; ++i) {
                const f32x4 wg = *(const f32x4*)(A.in[I_WG] + (size_t)i * 512 + cj); const float x3 = li[128 + i];
#pragma unroll
                for (int e = 0; e < 4; ++e) gl[e] += x3 * wg[e];
            }
            float r[4], kr[4], vr[4], kk[4]; float n2 = 0.f;
#pragma unroll
            for (int e = 0; e < 4; ++e) {
                r[e] = ysh(Y, row0 + tok, t0 + tok, C_R + cj + e, mu); kr[e] = ysh(Y, row0 + tok, t0 + tok, C_KR + cj + e, mu); vr[e] = ysh(Y, row0 + tok, t0 + tok, C_VR + cj + e, mu);
                kk[e] = kr[e] * A.in[I_KK][cj + e]; n2 += kk[e] * kk[e];
            }
            n2 += __shfl_xor(n2, 1); n2 += __shfl_xor(n2, 2); n2 += __shfl_xor(n2, 4); n2 += __shfl_xor(n2, 8);
            const float inv = 1.f / fmaxf(sqrtf(n2), L2_EPS);
            float bon = 0.f;
#pragma unroll
            for (int e = 0; e < 4; ++e) {
                const float a = sigmoidf_(al[e]); const float dec = __expf(-DECAY_SCALE * sigmoidf_(wl[e]));
                const float kn = kk[e] * inv; const float km = kr[e] * (1.f + (a - 1.f) * A.in[I_KA][cj + e]);
                bon += r[e] * km * A.in[I_RK][cj + e];
                const int o = tok * 64 + j0 + e;
                RR[o] = r[e]; WW[o] = dec; KM[o] = km; VV[o] = vr[e]; AV[o] = -kn; BV[o] = kn * a; GG[o] = gl[e];
            }
            bon += __shfl_xor(bon, 1); bon += __shfl_xor(bon, 2); bon += __shfl_xor(bon, 4); bon += __shfl_xor(bon, 8);
            if (jg == 0) BON[tok] = bon;
        }
        __syncthreads();
        {
            const int v = tid >> 3, kq = tid & 7;
#pragma unroll 1
            for (int t = 0; t < 32; ++t) {
                const int o = t * 64 + 8 * kq;
                const f32x4 a0 = *(const LAS f32x4*)(AV + o), a1 = *(const LAS f32x4*)(AV + o + 4), w0 = *(const LAS f32x4*)(WW + o), w1 = *(const LAS f32x4*)(WW + o + 4);
                const f32x4 b0 = *(const LAS f32x4*)(BV + o), b1 = *(const LAS f32x4*)(BV + o + 4), k0 = *(const LAS f32x4*)(KM + o), k1 = *(const LAS f32x4*)(KM + o + 4);
                const f32x4 r0 = *(const LAS f32x4*)(RR + o), r1 = *(const LAS f32x4*)(RR + o + 4);
                const float vv = VV[t * 64 + v];
                float sa = 0.f;
#pragma unroll
                for (int e = 0; e < 4; ++e) sa += s[e] * a0[e] + s[4 + e] * a1[e];
                sa += __shfl_xor(sa, 1); sa += __shfl_xor(sa, 2); sa += __shfl_xor(sa, 4);
                float oo = 0.f;
#pragma unroll
                for (int e = 0; e < 4; ++e) {
                    s[e] = s[e] * w0[e] + sa * b0[e] + vv * k0[e]; s[4 + e] = s[4 + e] * w1[e] + sa * b1[e] + vv * k1[e];
                    oo += s[e] * r0[e] + s[4 + e] * r1[e];
                }
                oo += __shfl_xor(oo, 1); oo += __shfl_xor(oo, 2); oo += __shfl_xor(oo, 4);
                if (kq == 0) OB[t * 64 + v] = oo;
            }
        }
        __syncthreads();
        {
            const int tok = tid >> 4, jg = tid & 15, v0 = 4 * jg;
            float ov[4], sm = 0.f;
#pragma unroll
            for (int e = 0; e < 4; ++e) { ov[e] = OB[tok * 64 + v0 + e]; sm += ov[e]; }
            sm += __shfl_xor(sm, 1); sm += __shfl_xor(sm, 2); sm += __shfl_xor(sm, 4); sm += __shfl_xor(sm, 8);
            const float mean = sm * (1.f / 64.f); float q = 0.f;
#pragma unroll
            for (int e = 0; e < 4; ++e) { const float dlt = ov[e] - mean; q += dlt * dlt; }
            q += __shfl_xor(q, 1); q += __shfl_xor(q, 2); q += __shfl_xor(q, 4); q += __shfl_xor(q, 8);
            const float rstd = 1.f / sqrtf(q * (1.f / 64.f) + GN_EPS);
            const float bon = BON[tok];
            float res[4];
#pragma unroll
            for (int e = 0; e < 4; ++e) { const int cj = h * 64 + v0 + e;
                const float on = (ov[e] - mean) * rstd * A.in[I_GNG][cj] + A.in[I_GNB][cj];
                res[e] = (on + bon * VV[tok * 64 + v0 + e]) * GG[tok * 64 + v0 + e]; }
            u32x2 w; w.x = pk2(res[0], res[1]); w.y = pk2(res[2], res[3]);
            *(u32x2*)(MIX + (row0 + tok) * DM + 512 + h * 64 + v0) = w;
        }
    }
}

__device__ __forceinline__ float wave_sum(float v) {
#pragma unroll
    for (int o = 1; o < 64; o <<= 1) v += __shfl_xor(v, o);
    return v;
}
__device__ __forceinline__ void ln_rows_phase(const float* in, const float* g, const float* bta, float* outf, bf16_t* outb, int vcu, int G, int tid) {
    const int lane = tid & 63, wave = tid >> 6;
    f32x4 gv[4], bv[4];
#pragma unroll
    for (int j = 0; j < 4; ++j) { gv[j] = *(const f32x4*)(g + 4 * lane + 256 * j); bv[j] = *(const f32x4*)(bta + 4 * lane + 256 * j); }
    for (int m = vcu * NWAVES + wave; m < M; m += G * NWAVES) {
        const f32x4* xr = (const f32x4*)(in + (size_t)m * DM) + lane;
        f32x4 v[4]; float s = 0.f;
#pragma unroll
        for (int j = 0; j < 4; ++j) { v[j] = xr[64 * j]; s += (v[j][0] + v[j][1]) + (v[j][2] + v[j][3]); }
        const float mean = wave_sum(s) * (1.f / DM); float s2 = 0.f;
#pragma unroll
        for (int j = 0; j < 4; ++j) { v[j] = v[j] - mean; s2 += (v[j][0] * v[j][0] + v[j][1] * v[j][1]) + (v[j][2] * v[j][2] + v[j][3] * v[j][3]); }
        const float rstd = 1.f / sqrtf(wave_sum(s2) * (1.f / DM) + LN_EPS);
#pragma unroll
        for (int j = 0; j < 4; ++j) {
            const f32x4 o = v[j] * rstd * gv[j] + bv[j];
            *((f32x4*)(outf + (size_t)m * DM) + lane + 64 * j) = o;
            if (outb) { u32x2 w; w.x = pk2(o[0], o[1]); w.y = pk2(o[2], o[3]); *((u32x2*)(outb + (size_t)m * DM) + lane + 64 * j) = w; }
        }
    }
}


constexpr int RW_SLOT = 8192;
constexpr int RW_SEG = 16 * RW_SLOT, RW_DG = RW_SEG + 2048, RW_BON = RW_DG + 256, RW_BONP = RW_BON + 256;
constexpr size_t WS_RWPT = 0;
constexpr size_t WS_RWQT = 32 * MiB;
constexpr size_t WS_RWS0 = 96 * MiB;

__device__ __forceinline__ int rw_swz(int row) { return (((row >> 1) & 1) << 1) | (((row >> 3) & 1) << 2); }
__device__ __forceinline__ int rw_off(int row, int chunk) { return row * 128 + ((chunk ^ rw_swz(row)) << 4); }
typedef float f32x2v __attribute__((ext_vector_type(2)));

template <int COL> __device__ __forceinline__ bf16x8 rw_frag(const LAS unsigned char* img, int u0, int s0, int fr, int fq) {
    if (COL == 0) {
        return *(const LAS bf16x8*)(img + rw_off(u0 + fr, (s0 >> 3) + fq));
    } else {
        const int rlo = s0 + 8 * fq + (fr >> 2), rhi = rlo + 4, p = fr & 3, ch = (u0 >> 3) + (p >> 1), sub = 8 * (p & 1);
        const s16x4 lo = vtr(img + rw_off(rlo, ch) + sub), hi = vtr(img + rw_off(rhi, ch) + sub);
        return (bf16x8){lo[0], lo[1], lo[2], lo[3], hi[0], hi[1], hi[2], hi[3]};
    }
}
template <int FCOL, int SCOL, int NPT> __device__ __forceinline__ void rw_mm(f32x4 (&acc)[NPT], const LAS unsigned char* imgF, const LAS unsigned char* imgS, int p0, int q0, int fr, int fq) {
#pragma unroll
    for (int ks = 0; ks < 2; ++ks) {
        const bf16x8 sf = rw_frag<SCOL>(imgS, q0, 32 * ks, fr, fq);
#pragma unroll
        for (int pt = 0; pt < NPT; ++pt) { const bf16x8 ff = rw_frag<FCOL>(imgF, p0 + 16 * pt, 32 * ks, fr, fq); acc[pt] = __builtin_amdgcn_mfma_f32_16x16x32_bf16(ff, sf, acc[pt], 0, 0, 0); }
    }
}
__device__ __forceinline__ void rw_store4(LAS unsigned char* img, int q, int p, f32x4 v) {
    u32x2 w; w.x = pk2(v[0], v[1]); w.y = pk2(v[2], v[3]);
    *(LAS u32x2*)(img + rw_off(q, p >> 3) + (p & 7) * 2) = w;
}
__device__ __forceinline__ f32x4 rw_load4(const LAS unsigned char* img, int q, int p) {
    const u32x2 w = *(const LAS u32x2*)(img + rw_off(q, p >> 3) + (p & 7) * 2);
    return (f32x4){bf2f(w.x & 0xffffu), bf2f(w.x >> 16), bf2f(w.y & 0xffffu), bf2f(w.y >> 16)};
}

template <int PASS> __device__ __forceinline__ void rwkv_chunk_phase(LAS unsigned char* lds, const Args& A, const bf16_t* Y, bf16_t* MIX, unsigned char* scr  , int vcu, int G, int tid) {
    const int lane = tid & 63, wid = __builtin_amdgcn_readfirstlane(tid >> 6);
    int fr = lane & 15, fq = lane >> 4;
    const int wr = wid & 3, wc = wid >> 2, q0 = 16 * wr, p0 = 32 * wc;
#define RELAUNDER() asm volatile("" : "+v"(fr), "+v"(fq))
#define SLOT(i) (lds + (i) * RW_SLOT)
    LAS unsigned char* const GGi = SLOT(0);
    LAS unsigned char* const ATi = SLOT(1); LAS unsigned char* const BTi = SLOT(2); LAS unsigned char* const KTi = SLOT(3); LAS unsigned char* const RTi = SLOT(4);
    LAS unsigned char* const BHi = SLOT(5); LAS unsigned char* const KHi = SLOT(6); LAS unsigned char* const VTi = SLOT(7);
    LAS unsigned char* const WDi = SLOT(1); LAS unsigned char* const WAi = SLOT(2); LAS unsigned char* const WG0i = SLOT(3); LAS unsigned char* const WG1i = SLOT(4);
    LAS unsigned char* const TDi = SLOT(5); LAS unsigned char* const DAi = SLOT(6); LAS unsigned char* const SG0i = SLOT(7); LAS unsigned char* const SG1i = SLOT(8);
    LAS float* const LW = (LAS float*)SLOT(9);
    LAS float* const AA = (LAS float*)SLOT(11);
    LAS unsigned char* const NABi = SLOT(8); LAS unsigned char* const NAKi = SLOT(9); LAS unsigned char* const MBRi = SLOT(10); LAS unsigned char* const MKRi = SLOT(11);
    LAS unsigned char* const NIa = SLOT(12); LAS unsigned char* const NIb = SLOT(13); LAS unsigned char* const TPa = SLOT(14); LAS unsigned char* const TPb = SLOT(15);
    LAS unsigned char* const XMi = SLOT(2); LAS unsigned char* const YKi = SLOT(3);
    LAS unsigned char* const ZIi = SLOT(12); LAS unsigned char* const ETi = SLOT(13); LAS unsigned char* const FIi = SLOT(15); LAS unsigned char* const S0i = SLOT(8);
    LAS float* const SEG = (LAS float*)(lds + RW_SEG);
    LAS float* const DG = (LAS float*)(lds + RW_DG);
    LAS float* const BON = (LAS float*)(lds + RW_BON);
    const float* mu = A.in[I_MU];
    for (int item = vcu; item < 4096; item += G) {
        const int chain = item >> 7, ci = item & 127;
        const int b = chain >> 3, h = chain & 7, t0 = ci * 64;
        const size_t row0 = (size_t)b * SEQ + t0;
        for (int it = tid; it < 2048; it += NTHREADS) {
            const int i = it >> 3, c = it & 7;
            const float* src = (i < 64) ? A.in[I_WD] + (size_t)i * 512 : (i < 128) ? A.in[I_WA] + (size_t)(i - 64) * 512 : A.in[I_WG] + (size_t)(i - 128) * 512;
            const f32x4 a = *(const f32x4*)(src + h * 64 + 8 * c), bq = *(const f32x4*)(src + h * 64 + 8 * c + 4);
            u32x4 o; o.x = pk2(a[0], a[1]); o.y = pk2(a[2], a[3]); o.z = pk2(bq[0], bq[1]); o.w = pk2(bq[2], bq[3]);
            *(LAS u32x4*)(SLOT(1 + (i >> 6)) + rw_off(i & 63, c)) = o;
        }
        for (int it = tid; it < 2048; it += NTHREADS) {
            const int t = it >> 5, c = it & 31;
            const bf16_t* yc = Y + (row0 + t) * INC + C_DW + 8 * c;
            const u32x4 cur = *(const u32x4*)yc; u32x4 prv = {0u, 0u, 0u, 0u};
            if (t0 + t > 0) prv = *(const u32x4*)(yc - INC);
            const f32x4 m0 = *(const f32x4*)(mu + (C_DW - C_RW) + 8 * c), m1 = *(const f32x4*)(mu + (C_DW - C_RW) + 8 * c + 4);
            float v[8];
#pragma unroll
            for (int e = 0; e < 4; ++e) {
                const float c0 = bf2f(cur[e] & 0xffffu), c1 = bf2f(cur[e] >> 16), q0_ = bf2f(prv[e] & 0xffffu), q1_ = bf2f(prv[e] >> 16);
                const float ma = (e < 2) ? m0[2 * e] : m1[2 * e - 4], mb = (e < 2) ? m0[2 * e + 1] : m1[2 * e - 3];
                v[2 * e] = c0 + ma * (q0_ - c0); v[2 * e + 1] = c1 + mb * (q1_ - c1);
            }
            if (c < 8) {
#pragma unroll
                for (int e = 0; e < 8; ++e) { const float ex = __expf(2.f * v[e]); v[e] = 1.f - 2.f / (ex + 1.f); }
            } else if (c >= 16) {
#pragma unroll
                for (int e = 0; e < 8; ++e) v[e] = sigmoidf_(v[e]);
            }
            u32x4 o; o.x = pk2(v[0], v[1]); o.y = pk2(v[2], v[3]); o.z = pk2(v[4], v[5]); o.w = pk2(v[6], v[7]);
            *(LAS u32x4*)(SLOT(5 + (c >> 3)) + rw_off(t, c & 7)) = o;
        }
        __syncthreads();
        RELAUNDER();
        {
            f32x4 aw[2] = {}, aa[2] = {}, ag[2] = {};
            rw_mm<1, 0, 2>(aw, WDi, TDi, p0, q0, fr, fq);
            rw_mm<1, 0, 2>(aa, WAi, DAi, p0, q0, fr, fq);
            rw_mm<1, 0, 2>(ag, WG0i, SG0i, p0, q0, fr, fq);
            rw_mm<1, 0, 2>(ag, WG1i, SG1i, p0, q0, fr, fq);
            const int t = q0 + fr;
#pragma unroll
            for (int pt = 0; pt < 2; ++pt) {
                const int j = p0 + 16 * pt + 4 * fq;
                const f32x4 w0v = *(const f32x4*)(A.in[I_W0] + h * 64 + j), a0v = *(const f32x4*)(A.in[I_A0] + h * 64 + j);
                f32x4 lw, av;
#pragma unroll
                for (int e = 0; e < 4; ++e) { lw[e] = -DECAY_SCALE * sigmoidf_(aw[pt][e] + w0v[e]); av[e] = sigmoidf_(aa[pt][e] + a0v[e]); }
                *(LAS f32x4*)(LW + t * 64 + j) = lw; *(LAS f32x4*)(AA + t * 64 + j) = av;
                rw_store4(GGi, t, j, ag[pt]);
            }
        }
        __syncthreads();
        {
            const int j = tid & 63, seg = tid >> 6; float acc = 0.f;
#pragma unroll
            for (int i = 0; i < 8; ++i) { const int t = 8 * seg + i; acc += LW[t * 64 + j]; LW[t * 64 + j] = acc; }
            SEG[seg * 64 + j] = acc;
        }
        __syncthreads();
        {
            int t = tid >> 3, jg = tid & 7; asm volatile("" : "+v"(t), "+v"(jg));
            const int j0 = 8 * jg, cj = h * 64 + j0, seg = t >> 3;
            const bf16_t* yr = Y + (row0 + t) * INC;
            const bool hasprev = (t0 + t > 0);
            u32x4 kcur = *(const u32x4*)(yr + C_KR + cj), kprv = {0u, 0u, 0u, 0u}; if (hasprev) kprv = *(const u32x4*)(yr + C_KR + cj - INC);
            u32x4 rcur = *(const u32x4*)(yr + C_R + cj), rprv = {0u, 0u, 0u, 0u}; if (hasprev) rprv = *(const u32x4*)(yr + C_R + cj - INC);
            u32x4 vcur = *(const u32x4*)(yr + C_VR + cj), vprv = {0u, 0u, 0u, 0u}; if (hasprev) vprv = *(const u32x4*)(yr + C_VR + cj - INC);
            float n2 = 0.f;
#pragma unroll
            for (int e = 0; e < 8; ++e) {
                const unsigned cw = kcur[e >> 1], pw = kprv[e >> 1];
                const float c = (e & 1) ? bf2f(cw >> 16) : bf2f(cw & 0xffffu), q = (e & 1) ? bf2f(pw >> 16) : bf2f(pw & 0xffffu);
                const float x = c + mu[C_KR - C_RW + cj + e] * (q - c);
                const float kk = x * A.in[I_KK][cj + e]; n2 += kk * kk;
            }
            n2 += __shfl_xor(n2, 1); n2 += __shfl_xor(n2, 2); n2 += __shfl_xor(n2, 4);
            const float inv = 1.f / fmaxf(sqrtf(n2), L2_EPS);
            u32x4 pat, pbt, pkt, prt, pbh, pkh, pvt; float bon = 0.f;
#pragma unroll
            for (int e2 = 0; e2 < 4; ++e2) {
                float at[2], bt[2], kt[2], rt[2], bh[2], kh[2], vv[2];
#pragma unroll
                for (int u = 0; u < 2; ++u) {
                    const int e = 2 * e2 + u, j = j0 + e;
                    const float kc = u ? bf2f(kcur[e2] >> 16) : bf2f(kcur[e2] & 0xffffu), kq = u ? bf2f(kprv[e2] >> 16) : bf2f(kprv[e2] & 0xffffu);
                    const float rc = u ? bf2f(rcur[e2] >> 16) : bf2f(rcur[e2] & 0xffffu), rq = u ? bf2f(rprv[e2] >> 16) : bf2f(rprv[e2] & 0xffffu);
                    const float vc = u ? bf2f(vcur[e2] >> 16) : bf2f(vcur[e2] & 0xffffu), vq = u ? bf2f(vprv[e2] >> 16) : bf2f(vprv[e2] & 0xffffu);
                    const float kr = kc + mu[C_KR - C_RW + cj + e] * (kq - kc), r = rc + mu[C_R - C_RW + cj + e] * (rq - rc), vr = vc + mu[C_VR - C_RW + cj + e] * (vq - vc);
                    float pre = 0.f, gc = 0.f;
#pragma unroll
                    for (int sgi = 0; sgi < 8; ++sgi) { const float sv = SEG[sgi * 64 + j]; gc += sv; pre += (sgi < seg) ? sv : 0.f; }
                    const float gp = LW[t * 64 + j], gprev = (t & 7) ? LW[(t - 1) * 64 + j] : 0.f;
                    const float gt = gp + pre, gm1 = gprev + pre;
                    const float a = AA[t * 64 + j];
                    const float kn = kr * A.in[I_KK][cj + e] * inv, km = kr * (1.f + (a - 1.f) * A.in[I_KA][cj + e]);
                    const float bvv = kn * a;
                    const float eg = __expf(gt), egm1 = __expf(gm1), eng = __expf(-gt), egc = __expf(gc - gt);
                    at[u] = -kn * egm1; rt[u] = r * eg; bt[u] = bvv * eng; kt[u] = km * eng; bh[u] = bvv * egc; kh[u] = km * egc; vv[u] = vr;
                    bon += r * km * A.in[I_RK][cj + e];
                    if (t == 63) DG[j] = __expf(gc);
                }
                pat[e2] = pk2(at[0], at[1]); pbt[e2] = pk2(bt[0], bt[1]); pkt[e2] = pk2(kt[0], kt[1]); prt[e2] = pk2(rt[0], rt[1]);
                pbh[e2] = pk2(bh[0], bh[1]); pkh[e2] = pk2(kh[0], kh[1]); pvt[e2] = pk2(vv[0], vv[1]);
            }
            bon += __shfl_xor(bon, 1); bon += __shfl_xor(bon, 2); bon += __shfl_xor(bon, 4);
            if (jg == 0) BON[t] = bon;
            const int off = rw_off(t, jg);
            *(LAS u32x4*)(ATi + off) = pat; *(LAS u32x4*)(BTi + off) = pbt; *(LAS u32x4*)(KTi + off) = pkt; *(LAS u32x4*)(RTi + off) = prt;
            *(LAS u32x4*)(BHi + off) = pbh; *(LAS u32x4*)(KHi + off) = pkh; *(LAS u32x4*)(VTi + off) = pvt;
        }
        __syncthreads();
        RELAUNDER();
        f32x4 tp[2], ni[2];
        {
            f32x4 nab[2] = {}, nak[2] = {};
            rw_mm<0, 0, 2>(nab, ATi, BTi, p0, q0, fr, fq);
            rw_mm<0, 0, 2>(nak, ATi, KTi, p0, q0, fr, fq);
            const int jrow = q0 + fr;
#pragma unroll
            for (int pt = 0; pt < 2; ++pt) {
                const int tc = p0 + 16 * pt + 4 * fq;
#pragma unroll
                for (int e = 0; e < 4; ++e) { const bool keep = jrow < tc + e; nab[pt][e] = keep ? nab[pt][e] : 0.f; nak[pt][e] = keep ? nak[pt][e] : 0.f; }
                rw_store4(NABi, jrow, tc, nab[pt]); rw_store4(NAKi, jrow, tc, nak[pt]);
                tp[pt] = nab[pt]; ni[pt] = nab[pt];
            }
            if (PASS == 3) {
                f32x4 mbr[2] = {}, mkr[2] = {};
                rw_mm<0, 0, 2>(mbr, RTi, BTi, p0, q0, fr, fq);
                rw_mm<0, 0, 2>(mkr, RTi, KTi, p0, q0, fr, fq);
#pragma unroll
                for (int pt = 0; pt < 2; ++pt) {
                    const int tc = p0 + 16 * pt + 4 * fq;
#pragma unroll
                    for (int e = 0; e < 4; ++e) { const bool keep = jrow <= tc + e; mbr[pt][e] = keep ? mbr[pt][e] : 0.f; mkr[pt][e] = keep ? mkr[pt][e] : 0.f; }
                    rw_store4(MBRi, jrow, tc, mbr[pt]); rw_store4(MKRi, jrow, tc, mkr[pt]);
                }
            }
        }
        __syncthreads();
        RELAUNDER();
        {
            { f32x4 n1[2] = {}; rw_mm<1, 0, 2>(n1, NABi, NABi, p0, q0, fr, fq);
#pragma unroll
              for (int pt = 0; pt < 2; ++pt) { rw_store4(NIb, q0 + fr, p0 + 16 * pt + 4 * fq, n1[pt]); ni[pt] = n1[pt]; } }
            __syncthreads();
#pragma unroll
            for (int it = 1; it <= 4; ++it) {
                const LAS unsigned char* ncur = (it & 1) ? NIb : NIa; LAS unsigned char* nnxt = (it & 1) ? NIa : NIb;
                const LAS unsigned char* tprev = (it == 1) ? NABi : ((it & 1) ? TPb : TPa); LAS unsigned char* tnxt = (it & 1) ? TPa : TPb;
                f32x4 n2[2] = {}, pr[2] = {};
                rw_mm<1, 0, 2>(n2, ncur, ncur, p0, q0, fr, fq);
                rw_mm<1, 0, 2>(pr, ncur, tprev, p0, q0, fr, fq);
#pragma unroll
                for (int pt = 0; pt < 2; ++pt) { tp[pt] = tp[pt] + ni[pt] + pr[pt]; ni[pt] = n2[pt];
                    rw_store4(nnxt, q0 + fr, p0 + 16 * pt + 4 * fq, n2[pt]); rw_store4(tnxt, q0 + fr, p0 + 16 * pt + 4 * fq, tp[pt]); }
                __syncthreads();
            }
            { f32x4 pr[2] = {}; rw_mm<1, 0, 2>(pr, NIb, TPb, p0, q0, fr, fq);
#pragma unroll
              for (int pt = 0; pt < 2; ++pt) { tp[pt] = tp[pt] + ni[pt] + pr[pt];
#pragma unroll
                  for (int e = 0; e < 4; ++e) if (q0 + fr == p0 + 16 * pt + 4 * fq + e) tp[pt][e] += 1.f;
                  rw_store4(TPa, q0 + fr, p0 + 16 * pt + 4 * fq, tp[pt]); } }
            __syncthreads();
        }
        RELAUNDER();
        {
            f32x4 xm[2] = {}, yk[2] = {};
            rw_mm<1, 1, 2>(xm, TPa, ATi, p0, q0, fr, fq);
            rw_mm<1, 0, 2>(yk, TPa, NAKi, p0, q0, fr, fq);
            __syncthreads();
#pragma unroll
            for (int pt = 0; pt < 2; ++pt) { rw_store4(XMi, q0 + fr, p0 + 16 * pt + 4 * fq, xm[pt]); rw_store4(YKi, q0 + fr, p0 + 16 * pt + 4 * fq, yk[pt]); }
        }
        __syncthreads();
        RELAUNDER();
        if (PASS == 1) {
            {
                f32x4 pt_[2] = {};
                rw_mm<0, 1, 2>(pt_, XMi, BHi, p0, q0, fr, fq);
                const int kp = q0 + fr;
                unsigned char* dst = scr + WS_RWPT + (size_t)item * 8192;
#pragma unroll
                for (int pt = 0; pt < 2; ++pt) {
                    const int k = p0 + 16 * pt + 4 * fq;
                    f32x4 v = pt_[pt];
#pragma unroll
                    for (int e = 0; e < 4; ++e) if (k + e == kp) v[e] += DG[kp];
                    const int i = kp >> 5, r32 = kp & 31, tt = k >> 5, s1 = (k >> 4) & 1, jj = (k >> 3) & 1, hh = (k >> 2) & 1;
                    u32x2 w; w.x = pk2(v[0], v[1]); w.y = pk2(v[2], v[3]);
                    *(u32x2*)(dst + ((i * 4 + 2 * tt + s1) * 64 + r32 + 32 * hh) * 16 + 8 * jj) = w;
                }
            }
            {
                f32x4 z[2] = {};
                rw_mm<1, 0, 2>(z, BHi, YKi, p0, q0, fr, fq);
#pragma unroll
                for (int pt = 0; pt < 2; ++pt) { const int kc = p0 + 16 * pt + 4 * fq; z[pt] = z[pt] + rw_load4(KHi, q0 + fr, kc); rw_store4(ZIi, q0 + fr, kc, z[pt]); }
            }
            __syncthreads();
            RELAUNDER();
            {
                f32x4 qc[2] = {};
                rw_mm<1, 1, 2>(qc, ZIi, VTi, p0, q0, fr, fq);
                const int v = q0 + fr, vh = v >> 5, r32v = v & 31;
                unsigned char* dst = scr + WS_RWQT + (size_t)item * 16384;
#pragma unroll
                for (int pt = 0; pt < 2; ++pt) {
                    const int kp = p0 + 16 * pt + 4 * fq;
                    const int i = kp >> 5, rr = (kp >> 3) & 3, hh = (kp >> 2) & 1;
                    *(f32x4*)(dst + ((((size_t)vh * 2 + i) * 4 + rr) * 64 + r32v + 32 * hh) * 16) = qc[pt];
                }
            }
        } else {
            {
                f32x4 et[2] = {}, fi[2] = {};
                rw_mm<0, 1, 2>(et, XMi, MBRi, p0, q0, fr, fq);
                rw_mm<1, 0, 2>(fi, MBRi, YKi, p0, q0, fr, fq);
#pragma unroll
                for (int pt = 0; pt < 2; ++pt) { const int c = p0 + 16 * pt + 4 * fq;
                    et[pt] = et[pt] + rw_load4(RTi, q0 + fr, c); fi[pt] = fi[pt] + rw_load4(MKRi, q0 + fr, c);
                    rw_store4(ETi, q0 + fr, c, et[pt]); rw_store4(FIi, q0 + fr, c, fi[pt]); }
            }
            { const unsigned char* src = scr + WS_RWS0 + (size_t)item * 8192; const int row = tid >> 3, c = tid & 7;
              *(LAS u32x4*)(S0i + rw_off(row, c)) = *(const u32x4*)(src + row * 128 + c * 16); }
            __syncthreads();
            RELAUNDER();
            if (wid < 4) {
                f32x4 o[4] = {};
                const int tq = 16 * wid;
                rw_mm<0, 0, 4>(o, S0i, ETi, 0, tq, fr, fq);
                rw_mm<1, 1, 4>(o, VTi, FIi, 0, tq, fr, fq);
                const int t = tq + fr;
                float sm = 0.f;
#pragma unroll
                for (int pt = 0; pt < 4; ++pt) sm += (o[pt][0] + o[pt][1]) + (o[pt][2] + o[pt][3]);
                sm += __shfl_xor(sm, 16); sm += __shfl_xor(sm, 32);
                const float mean = sm * (1.f / 64.f); float q = 0.f;
#pragma unroll
                for (int pt = 0; pt < 4; ++pt)
#pragma unroll
                    for (int e = 0; e < 4; ++e) { const float d = o[pt][e] - mean; q += d * d; }
                q += __shfl_xor(q, 16); q += __shfl_xor(q, 32);
                const float rstd = 1.f / sqrtf(q * (1.f / 64.f) + GN_EPS), bon = BON[t];
                bf16_t* orow = MIX + (row0 + t) * DM + 512 + h * 64;
#pragma unroll
                for (int pt = 0; pt < 4; ++pt) {
                    const int v = 16 * pt + 4 * fq;
                    const f32x4 gg = *(const f32x4*)(A.in[I_GNG] + h * 64 + v), gb = *(const f32x4*)(A.in[I_GNB] + h * 64 + v);
                    const f32x4 vv = rw_load4(VTi, t, v), gate = rw_load4(GGi, t, v);
                    f32x4 res;
#pragma unroll
                    for (int e = 0; e < 4; ++e) res[e] = ((o[pt][e] - mean) * rstd * gg[e] + gb[e] + bon * vv[e]) * gate[e];
                    u32x2 w; w.x = pk2(res[0], res[1]); w.y = pk2(res[2], res[3]);
                    *(u32x2*)(orow + v) = w;
                }
            }
        }
        __syncthreads();
    }
#undef SLOT
}

struct ScanRegs { bf16x8 a[2][4]; f32x4 q[2][4]; };
__device__ __forceinline__ void scan_load(ScanRegs& R, const unsigned char* pt, const unsigned char* qt, int c, int lane) {
#pragma unroll
    for (int i = 0; i < 2; ++i)
#pragma unroll
        for (int s = 0; s < 4; ++s) { R.a[i][s] = *(const bf16x8*)(pt + (size_t)c * 8192 + ((i * 4 + s) * 64 + lane) * 16); R.q[i][s] = *(const f32x4*)(qt + (size_t)c * 16384 + ((i * 4 + s) * 64 + lane) * 16); }
}
__device__ __forceinline__ void scan_step(const ScanRegs& R, f32x16& x0, f32x16& x1, unsigned char* s0row, int hh) {
    f32x16 n0, n1;
#pragma unroll
    for (int rr = 0; rr < 4; ++rr)
#pragma unroll
        for (int e = 0; e < 4; ++e) { n0[4 * rr + e] = R.q[0][rr][e]; n1[4 * rr + e] = R.q[1][rr][e]; }
    u32x4 bw[4];
#pragma unroll
    for (int s = 0; s < 4; ++s) {
        const f32x16& xs = (s < 2) ? x0 : x1; const int o = 8 * (s & 1);
        bw[s].x = pk2(xs[o + 0], xs[o + 1]); bw[s].y = pk2(xs[o + 2], xs[o + 3]); bw[s].z = pk2(xs[o + 4], xs[o + 5]); bw[s].w = pk2(xs[o + 6], xs[o + 7]);
    }
#pragma unroll
    for (int s = 0; s < 4; ++s) {
        const int tt = s >> 1, g0 = 2 * (s & 1);
        *(u32x2*)(s0row + (32 * tt + 8 * g0 + 4 * hh) * 2) = (u32x2){bw[s].x, bw[s].y};
        *(u32x2*)(s0row + (32 * tt + 8 * (g0 + 1) + 4 * hh) * 2) = (u32x2){bw[s].z, bw[s].w};
    }
#pragma unroll
    for (int s = 0; s < 4; ++s) {
        const bf16x8 bf = __builtin_bit_cast(bf16x8, bw[s]);
        n0 = __builtin_amdgcn_mfma_f32_32x32x16_bf16(R.a[0][s], bf, n0, 0, 0, 0);
        n1 = __builtin_amdgcn_mfma_f32_32x32x16_bf16(R.a[1][s], bf, n1, 0, 0, 0);
    }
    x0 = n0; x1 = n1;
}
__device__ __forceinline__ void rwkv_scan_phase(unsigned char* scr, int vcu, int tid) {
    if (vcu >= 64 || tid >= 64) return;
    const int lane = tid, chain = vcu >> 1, vh = vcu & 1, r32 = lane & 31, hh = lane >> 5;
    f32x16 x0 = {}, x1 = {};
    const unsigned char* pt = scr + WS_RWPT + (size_t)chain * 128 * 8192;
    const unsigned char* qt = scr + WS_RWQT + (size_t)chain * 128 * 16384 + (size_t)vh * 8192;
    unsigned char* s0 = scr + WS_RWS0 + (size_t)chain * 128 * 8192 + (size_t)(32 * vh + r32) * 128;
    ScanRegs RA, RB;
    scan_load(RA, pt, qt, 0, lane);
#pragma unroll 1
    for (int c = 0; c < 128; c += 2) {
        scan_load(RB, pt, qt, c + 1, lane);
        scan_step(RA, x0, x1, s0 + (size_t)c * 8192, hh);
        scan_load(RA, pt, qt, (c + 2 < 128) ? c + 2 : c, lane);
        scan_step(RB, x0, x1, s0 + (size_t)(c + 1) * 8192, hh);
    }
}
#define GAS __attribute__((address_space(1)))
typedef GAS unsigned gu32;
typedef GAS unsigned long long gu64;
#define RLX_AGENT __ATOMIC_RELAXED, __HIP_MEMORY_SCOPE_AGENT
#define XB_TMO      128
#define XB_XCNT(j)  (256  + 64 * (j))
#define XB_XSUB(j)  (1280 + 64 * (j))
#define XB_XGEN(j)  (2304 + 64 * (j))
#define XB_TOP      3328
#define XB_TOPGEN   3392
#define XCD_BAR_WORDS 3456
#define XB_SPIN_CAP (1u << 18)

__device__ __forceinline__ unsigned xb_ld(unsigned* p)              { return __hip_atomic_load(p, __ATOMIC_RELAXED, __HIP_MEMORY_SCOPE_AGENT); }
__device__ __forceinline__ unsigned xb_add(unsigned* p, unsigned v) { return __hip_atomic_fetch_add(p, v, __ATOMIC_RELAXED, __HIP_MEMORY_SCOPE_AGENT); }
__device__ __forceinline__ unsigned xb_xcc_id() { return (unsigned)__builtin_amdgcn_s_getreg((3 << 11) | 20) & 0xFu; }
#define XB_SPIN(cond, bar) do { unsigned _sp = 0; while (cond) { __builtin_amdgcn_s_sleep(1); \
    if ((++_sp & 255u) == 0u) { if (xb_ld(&(bar)[XB_TMO])) break; if (_sp > XB_SPIN_CAP) { atomicAdd(&(bar)[XB_TMO], 1u); break; } } } } while (0)

struct XcdBarrier {
    unsigned* bar; unsigned x;
    volatile LAS unsigned* st;
};

__device__ __forceinline__ XcdBarrier xcd_barrier_post(unsigned* bar, volatile LAS unsigned* st) {
    XcdBarrier b; b.bar = bar; b.x = xb_xcc_id(); b.st = st;
    if (threadIdx.x == 0) (void)xb_add(&bar[XB_XCNT(b.x)], 1u);
    return b;
}
__device__ __forceinline__ void xcd_barrier_complete(unsigned* bar, unsigned x, unsigned& nloc, unsigned& nx) {
    const unsigned G = gridDim.x * gridDim.y * gridDim.z;
    unsigned sum, cnt, mine, sp = 0u;
    for (;;) {
        sum = 0u; cnt = 0u; mine = 0u;
#pragma unroll
        for (unsigned j = 0; j < 16; ++j) { const unsigned c = xb_ld(&bar[XB_XCNT(j)]); sum += c; cnt += (c > 0u) ? 1u : 0u; mine = (j == x) ? c : mine; }
        if (sum == G) break;
        __builtin_amdgcn_s_sleep(1);
        if ((++sp & 255u) == 0u) { if (xb_ld(&bar[XB_TMO])) break; if (sp > XB_SPIN_CAP) { atomicAdd(&bar[XB_TMO], 1u); break; } }
    }
    nloc = mine > 0u ? mine : 1u; nx = cnt > 0u ? cnt : 1u;
}

__device__ __forceinline__ void xcd_barrier(const XcdBarrier& b) {
    asm volatile("s_waitcnt vmcnt(0)" ::: "memory");
    __syncthreads();
    if (threadIdx.x == 0) {
        unsigned* bar = b.bar;
        __builtin_amdgcn_s_waitcnt(0);
        unsigned nloc = b.st[0], nx = b.st[1];
        if (nloc == 0u) { xcd_barrier_complete(bar, b.x, nloc, nx); b.st[0] = nloc; b.st[1] = nx; }
        const unsigned old = xb_add(&bar[XB_XSUB(b.x)], 1u);
        const unsigned gen = old / nloc;
        if (old + 1u == (gen + 1u) * nloc) {
            __builtin_amdgcn_fence(__ATOMIC_RELEASE, "agent");
            asm volatile("s_waitcnt vmcnt(0)" ::: "memory");
            const unsigned og = xb_add(&bar[XB_TOP], 1u);
            const unsigned tg = og / nx;
            if (og + 1u == (tg + 1u) * nx) xb_add(&bar[XB_TOPGEN], 1u);
            else XB_SPIN(xb_ld(&bar[XB_TOPGEN]) == tg, bar);
            __builtin_amdgcn_fence(__ATOMIC_ACQUIRE, "agent");
            xb_add(&bar[XB_XGEN(b.x)], 1u);
            asm volatile("s_waitcnt vmcnt(0)" ::: "memory");
        } else {
            XB_SPIN(xb_ld(&bar[XB_XGEN(b.x)]) == gen, bar);
            __builtin_amdgcn_fence(__ATOMIC_ACQUIRE, "agent");
            asm volatile("s_waitcnt vmcnt(0)" ::: "memory");
        }
    }
    __syncthreads();
}

constexpr int N_PHASES = 10;
#ifndef RW_DIRECT
#define RW_DIRECT 0
#endif
constexpr int MISC_OFF = 143360;
constexpr int CW_BAR = 4096;
constexpr size_t CTL_MEMSET_BYTES = 65536;
#ifndef ONE_LAUNCH
#define ONE_LAUNCH 1
#endif
__global__ void __launch_bounds__(NTHREADS, 2) fwd(Args args) {
    extern __shared__ __attribute__((aligned(16))) unsigned char lds_raw[];
    LAS unsigned char* lds = (LAS unsigned char*)lds_raw;
    const int tid = threadIdx.x, G = gridDim.x, bx = blockIdx.x;
    const int vcu = (G % 8 == 0) ? (bx % 8) * (G / 8) + bx / 8 : bx;
    unsigned char* ws = args.ws;
    bf16_t* Y = (bf16_t*)(ws + WS_Y); bf16_t* MIX = (bf16_t*)(ws + WS_MIX);
    const int lo = args.ph_lo, hi = args.ph_hi;
    volatile LAS unsigned* MISC = (volatile LAS unsigned*)(lds + MISC_OFF);
    if (tid < 32) MISC[tid] = 0u;
    __syncthreads();
    XcdBarrier bar; bar.bar = (unsigned*)(ws + WS_CTL) + CW_BAR; bar.x = 0; bar.st = nullptr;
    if (ONE_LAUNCH) bar = xcd_barrier_post((unsigned*)(ws + WS_CTL) + CW_BAR, MISC + 8);
#define GRID_BAR() do { if (ONE_LAUNCH) xcd_barrier(bar); } while (0)
#ifndef PHMASK
#define PHMASK 0xffff
#endif
#define IN(k) (((PHMASK >> (k)) & 1) && lo <= (k) && (k) < hi)
    if (IN(0)) { p0_prologue(args, lds, vcu, G, tid); GRID_BAR(); }
    if (IN(1)) {
        pg8::Gemm g{(const bf16_t*)(ws + WS_XB), (const bf16_t*)(ws + WS_WIN), M, INC, DM}; pg8::StaticOrder S; S.init(M, INC, G, bx);
        pg8::EpiInProj E{Y, (const float*)(ws + WS_CS), INC, QSCALE};
        pg8::gemm_phase<pg8::EpiInProj, pg8::StaticOrder, true, true>(lds, g, S, E);
        GRID_BAR();
    }
#if RW_DIRECT
    if (IN(2)) attn_partial_phase(lds, Y, (bf16_t*)(ws + WS_ATTP), (float*)(ws + WS_LSE), vcu, G, tid);
    if (IN(3)) { rwkv_direct_phase(lds, args, Y, MIX, vcu, tid); GRID_BAR(); }
    if (IN(4)) { attn_merge_phase((const bf16_t*)(ws + WS_ATTP), (const float*)(ws + WS_LSE), MIX, vcu, G, tid); GRID_BAR(); }
#else
    if (IN(2)) { attn_partial_phase(lds, Y, (bf16_t*)(ws + WS_ATTP), (float*)(ws + WS_LSE), vcu, G, tid);
                 rwkv_chunk_phase<1>(lds, args, Y, MIX, (unsigned char*)args.out, vcu, G, tid); GRID_BAR(); }
    if (IN(3)) { if (vcu < 64) rwkv_scan_phase((unsigned char*)args.out, vcu, tid);
                 else attn_merge_phase((const bf16_t*)(ws + WS_ATTP), (const float*)(ws + WS_LSE), MIX, vcu - 64, G - 64, tid);
                 GRID_BAR(); }
    if (IN(4)) { rwkv_chunk_phase<3>(lds, args, Y, MIX, (unsigned char*)args.out, vcu, G, tid); GRID_BAR(); }
#endif
    if (IN(5)) {
        pg8::Gemm g{MIX, (const bf16_t*)(ws + WS_WOUT), M, DM, DM}; pg8::StaticOrder S; S.init(M, DM, G, bx);
        pg8::EpiResF32 E{args.in[I_X], (float*)(ws + WS_TMP5), DM, ALPHA};
        pg8::gemm_phase<pg8::EpiResF32, pg8::StaticOrder, true, true>(lds, g, S, E);
        GRID_BAR();
    }
    if (IN(6)) { ln_rows_phase((const float*)(ws + WS_TMP5), args.in[I_LN1G], args.in[I_LN1B], args.out, (bf16_t*)(ws + WS_H1B), vcu, G, tid); GRID_BAR(); }
    if (IN(7)) {
        pg8::Gemm g{(const bf16_t*)(ws + WS_H1B), (const bf16_t*)(ws + WS_WGU), M, 2 * FF, DM}; pg8::StaticOrder S; S.init(M, 2 * FF, G, bx);
        pg8::EpiSwiGLU E{(bf16_t*)(ws + WS_HID), FF};
        pg8::gemm_phase<pg8::EpiSwiGLU, pg8::StaticOrder, true, true>(lds, g, S, E);
        GRID_BAR();
    }
    if (IN(8)) {
        pg8::Gemm g{(const bf16_t*)(ws + WS_HID), (const bf16_t*)(ws + WS_WDN), M, DM, FF}; pg8::StaticOrder S; S.init(M, DM, G, bx);
        pg8::EpiResF32 E{args.out, (float*)(ws + WS_TMP7), DM, ALPHA};
        pg8::gemm_phase<pg8::EpiResF32, pg8::StaticOrder, true, true>(lds, g, S, E);
        GRID_BAR();
    }
    if (IN(9)) ln_rows_phase((const float*)(ws + WS_TMP7), args.in[I_LN2G], args.in[I_LN2B], args.out, nullptr, vcu, G, tid);
#undef IN
}

extern "C" void kernel_launch(void* const* d_in, const int* in_sizes, int n_in, void* d_out, int out_size, void* d_ws, size_t ws_size, hipStream_t stream) {
    static int grid = 0;
    if (grid == 0) {
        if (n_in != 22 || out_size != M * DM || ws_size < WS_END) { fprintf(stderr, "kernel_launch: unexpected shapes (n_in %d out %d ws %zu)\n", n_in, out_size, ws_size); grid = -1; return; }
        int dev = 0, cus = 0;
        if (hipGetDevice(&dev) != hipSuccess || hipDeviceGetAttribute(&cus, hipDeviceAttributeMultiprocessorCount, dev) != hipSuccess) { grid = -1; return; }
        if (hipFuncSetAttribute((const void*)fwd, hipFuncAttributeMaxDynamicSharedMemorySize, LDS_BYTES) != hipSuccess) { fprintf(stderr, "kernel_launch: hipFuncSetAttribute failed\n"); grid = -1; return; }
        grid = cus;
    }
    if (grid < 0) return;
    Args a{};
    for (int i = 0; i < 22; ++i) a.in[i] = (const float*)d_in[i];
    a.pos = (const int*)d_in[1]; a.out = (float*)d_out; a.ws = (unsigned char*)d_ws;
    if (ONE_LAUNCH) {
        if (hipMemsetAsync((char*)d_ws + WS_CTL, 0, CTL_MEMSET_BYTES, stream) != hipSuccess) { fprintf(stderr, "kernel_launch: memset failed\n"); return; }
        a.ph_lo = 0; a.ph_hi = N_PHASES;
        hipLaunchKernelGGL(fwd, dim3(grid), dim3(NTHREADS), LDS_BYTES, stream, a);
    } else {
        for (int ph = 0; ph < N_PHASES; ++ph) { a.ph_lo = ph; a.ph_hi = ph + 1; hipLaunchKernelGGL(fwd, dim3(grid), dim3(NTHREADS), LDS_BYTES, stream, a); }
    }
}
```

```cpp
#include <hip/hip_runtime.h>
#include <cstdio>
#include <cstdint>
namespace pg8 {
#define PG8_LAS __attribute__((address_space(3)))
typedef unsigned short bf16_t;
typedef short bf16x8 __attribute__((ext_vector_type(8)));
typedef float f32x4 __attribute__((ext_vector_type(4)));
typedef unsigned u32x4 __attribute__((ext_vector_type(4)));
constexpr int BM = 256, BK = 64, HALF = 128, HTB = HALF * BK * 2  , STAGE_BYTES = 8 * HTB, NXCD = 8, WGM = 8;

__host__ __device__ __forceinline__ int lds_byte(int r, int c) { const int st = (r >> 4) * 2 + (c >> 5), rr = r & 15, cc = c & 31, ob = rr * 64 + cc * 2; return st * 1024 + (ob ^ (((ob >> 9) & 1) << 5)); }
__host__ __device__ __forceinline__ void stage_rc(int b, int& R, int& C) { const int st = b / 1024, sb = b % 1024, swz = sb ^ (((sb >> 9) & 1) << 5); R = (st >> 1) * 16 + swz / 64; C = (st & 1) * 32 + (swz % 64) / 2; }
__host__ __device__ __forceinline__ int perm32(int rho) { const int n = rho >> 4, i = rho & 15; return 8 * (i >> 2) + 4 * n + (i & 3); }

struct Unit { int pm, pn; };
struct Gemm { const bf16_t* A; const bf16_t* Bt; int M, N, K; };

struct StaticOrder {
    int nM, nN, nwg, G, c;
    __host__ __device__ void init(int M, int N, int G_, int c_) { nM = M / BM; nN = N / BM; nwg = nM * nN; G = G_; c = c_; }
    __host__ __device__ bool next(int i, Unit& u) const {
        const long L = (long)i * G + c; if (L >= nwg) return false;
        int wgid = (int)L; { const int q = nwg / NXCD, r = nwg % NXCD, xcd = wgid % NXCD, off = wgid / NXCD; wgid = (xcd < r ? xcd * (q + 1) : r * (q + 1) + (xcd - r) * q) + off; }
        const int nig = WGM * nN, gid = wgid / nig, fm = gid * WGM, gsz = (nM - fm) < WGM ? (nM - fm) : WGM;
        u.pm = fm + ((wgid % nig) % gsz); u.pn = (wgid % nig) / gsz; return true;
    }
    __device__ __forceinline__ void a_ready(const Unit&) const {}
    __device__ __forceinline__ void done(const Unit&) const {}
};


__device__ __forceinline__ unsigned cvt_pk_bf16(float lo, float hi) { unsigned r; asm volatile("v_cvt_pk_bf16_f32 %0, %1, %2" : "=v"(r) : "v"(lo), "v"(hi)); return r; }

struct EpiInProj {
    static constexpr bool PERM = true, AFTER_DRAIN = false;
    bf16_t* Y; const float* cs; int ldc; float qscale;
    __device__ __forceinline__ void operator()(const f32x4 (&acc)[2][2][4][2], const Unit& u, int wr, int wc, int fr, int fq) const {
        const int row0 = u.pm * BM + wr * 64 + fr, col0 = u.pn * BM + wc * 32 + 8 * fq;
        const bool rope = (u.pn < 4) && ((wc & 1) == 0);
        const float qs = (u.pn < 2) ? qscale : 1.f;
        const float sg = (fq == 0) ? -1.f : 1.f;
#pragma unroll
        for (int ai = 0; ai < 2; ++ai)
#pragma unroll
            for (int m = 0; m < 4; ++m) {
                const int row = row0 + ai * HALF + m * 16;
                bf16_t* rowp = Y + (size_t)row * ldc + col0;
                f32x4 c0 = {1.f, 1.f, 1.f, 1.f}, c1 = c0, s0 = {0.f, 0.f, 0.f, 0.f}, s1 = s0;
                if (rope) { const f32x4* cp = (const f32x4*)(cs + (size_t)row * 16); c0 = cp[0]; c1 = cp[1]; s0 = cp[2]; s1 = cp[3]; }
#pragma unroll
                for (int bj = 0; bj < 2; ++bj) {
                    f32x4 v0 = acc[ai][bj][m][0], v1 = acc[ai][bj][m][1];
                    if (rope) {
                        f32x4 o0, o1;
#pragma unroll
                        for (int e = 0; e < 4; ++e) { o0[e] = __shfl_xor(v0[e], 16); o1[e] = __shfl_xor(v1[e], 16); }
                        const f32x4 r0 = v0 * c0 + (o0 * s0) * sg, r1 = v1 * c1 + (o1 * s1) * sg;
                        if (fq < 2) { v0 = r0; v1 = r1; }
                    }
                    v0 = v0 * qs; v1 = v1 * qs;
                    u32x4 w; w.x = cvt_pk_bf16(v0[0], v0[1]); w.y = cvt_pk_bf16(v0[2], v0[3]); w.z = cvt_pk_bf16(v1[0], v1[1]); w.w = cvt_pk_bf16(v1[2], v1[3]);
                    *(u32x4*)(rowp + bj * HALF) = w;
                }
            }
    }
};

struct EpiSwiGLU {
    static constexpr bool PERM = true, AFTER_DRAIN = false;
    bf16_t* H; int ldc;
    __device__ __forceinline__ void operator()(const f32x4 (&acc)[2][2][4][2], const Unit& u, int wr, int wc, int fr, int fq) const {
        const int row0 = u.pm * BM + wr * 64 + fr, col0 = u.pn * HALF + wc * 32 + 8 * fq;
#pragma unroll
        for (int ai = 0; ai < 2; ++ai)
#pragma unroll
            for (int m = 0; m < 4; ++m) {
                bf16_t* rowp = H + (size_t)(row0 + ai * HALF + m * 16) * ldc + col0;
                float h[8];
#pragma unroll
                for (int n = 0; n < 2; ++n)
#pragma unroll
                    for (int e = 0; e < 4; ++e) { const float g = acc[ai][0][m][n][e], up = acc[ai][1][m][n][e];
                        const float sig = __builtin_amdgcn_rcpf(1.f + __builtin_amdgcn_exp2f(-1.4426950408889634f * g)); h[n * 4 + e] = g * sig * up; }
                u32x4 w; w.x = cvt_pk_bf16(h[0], h[1]); w.y = cvt_pk_bf16(h[2], h[3]); w.z = cvt_pk_bf16(h[4], h[5]); w.w = cvt_pk_bf16(h[6], h[7]);
                *(u32x4*)rowp = w;
            }
    }
};

struct EpiResF32 {
    static constexpr bool PERM = false, AFTER_DRAIN = false;
    const float* base; float* out; int ldc; float alpha;
    __device__ __forceinline__ void operator()(const f32x4 (&acc)[2][2][4][2], const Unit& u, int wr, int wc, int fr, int fq) const {
        const int row0 = u.pm * BM + wr * 64 + fr, col0 = u.pn * BM + wc * 32 + 4 * fq;
#pragma unroll
        for (int ai = 0; ai < 2; ++ai)
#pragma unroll
            for (int m = 0; m < 4; ++m) { const size_t off = (size_t)(row0 + ai * HALF + m * 16) * ldc + col0;
#pragma unroll
                for (int bj = 0; bj < 2; ++bj)
#pragma unroll
                    for (int n = 0; n < 2; ++n) { const f32x4 bs = *(const f32x4*)(base + off + bj * HALF + n * 16); *(f32x4*)(out + off + bj * HALF + n * 16) = bs * alpha + acc[ai][bj][m][n]; } }
    }
};

template <class Epi, class Sched, bool ALIGN_EPI = false, bool SP2 = false>
__device__ __forceinline__ void gemm_phase(PG8_LAS unsigned char* lds, const Gemm g, const Sched& S, const Epi& E) {
    const int tid = threadIdx.x, wid = __builtin_amdgcn_readfirstlane(tid >> 6), lane = tid & 63, wr = wid >> 2, wc = wid & 3, fr = lane & 15, fq = lane >> 4;
    const int K = g.K, nt = K / BK;
    unsigned voffA[2], voffB[2];
#pragma unroll
    for (int i = 0; i < 2; ++i) { int R, C; stage_rc(tid * 16 + i * 8192, R, C); const int Rb = Epi::PERM ? ((R & ~31) + perm32(R & 31)) : R;
        voffA[i] = (unsigned)(R * K + C) * 2u; voffB[i] = (unsigned)(Rb * K + C) * 2u; }
    const size_t kstep = (size_t)(BK * 2);
    const size_t hstep = (size_t)HALF * K * 2;
    const size_t tstep = 2 * hstep;
    const unsigned ldsw = (unsigned)wid * 1024u;
    const int aoff = lds_byte(wr * 64 + fr, fq * 8), boff = lds_byte(wc * 32 + fr, fq * 8);
#define PG8_SA(b, h) (((b) * 2 + (h)) * HTB)
#define PG8_SB(b, h) ((4 + (b) * 2 + (h)) * HTB)
#define PG8_STAGE(bufoff, gbase, voff) do { _Pragma("unroll") for (int _i = 0; _i < 2; ++_i) \
        __builtin_amdgcn_global_load_lds((const unsigned*)((const char*)(gbase) + (voff)[_i]), (PG8_LAS unsigned*)(lds + (bufoff) + ldsw + _i * 8192), 16, 0, 0); } while (0)
#define PG8_LDA(dst, b, h) do { _Pragma("unroll") for (int m = 0; m < 4; ++m) _Pragma("unroll") for (int k = 0; k < 2; ++k) dst[m][k] = *(const PG8_LAS bf16x8*)(lds + PG8_SA(b, h) + aoff + m * 2048 + k * 1024); } while (0)
#define PG8_LDB(dst, b, h) do { _Pragma("unroll") for (int n = 0; n < 2; ++n) _Pragma("unroll") for (int k = 0; k < 2; ++k) dst[n][k] = *(const PG8_LAS bf16x8*)(lds + PG8_SB(b, h) + boff + n * 2048 + k * 1024); } while (0)
#define PG8_MMA(ai, bj, At, Bt) do { __builtin_amdgcn_s_setprio(1); _Pragma("unroll") for (int m = 0; m < 4; ++m) _Pragma("unroll") for (int n = 0; n < 2; ++n) _Pragma("unroll") for (int k = 0; k < 2; ++k) \
        acc[ai][bj][m][n] = __builtin_amdgcn_mfma_f32_16x16x32_bf16(Bt[n][k], At[m][k], acc[ai][bj][m][n], 0, 0, 0); __builtin_amdgcn_s_setprio(0); } while (0)
#define PG8_WAIT_V(n) asm volatile("s_waitcnt vmcnt(" #n ")" ::: "memory")
#define PG8_WAIT_L(n) asm volatile("s_waitcnt lgkmcnt(" #n ")" ::: "memory")
#define PG8_BAR __builtin_amdgcn_s_barrier()
#define PG8_SCHED __builtin_amdgcn_sched_barrier(0)
    Unit cur, nxt; int ui = 0;
    if (!S.next(0, cur)) return;
    f32x4 acc[2][2][4][2];
#pragma unroll
    for (int a = 0; a < 2; ++a)
#pragma unroll
        for (int b = 0; b < 2; ++b)
#pragma unroll
            for (int m = 0; m < 4; ++m)
#pragma unroll
                for (int n = 0; n < 2; ++n) acc[a][b][m][n] = (f32x4){0.f, 0.f, 0.f, 0.f};
    bf16x8 At[4][2], B0[2][2], B1[2][2];
    const char* cA = (const char*)g.A + (size_t)cur.pm * tstep; const char* cB = (const char*)g.Bt + (size_t)cur.pn * tstep;
    S.a_ready(cur);
    if constexpr (SP2) {
        PG8_STAGE(PG8_SB(0, 0), cB, voffB); PG8_STAGE(PG8_SB(0, 1), cB + hstep, voffB); PG8_STAGE(PG8_SA(0, 0), cA, voffA); PG8_STAGE(PG8_SA(0, 1), cA + hstep, voffA);
        if (wr == 1) PG8_BAR;
        PG8_WAIT_V(2); PG8_BAR;
        PG8_STAGE(PG8_SB(1, 0), cB + kstep, voffB); PG8_STAGE(PG8_SA(1, 0), cA + kstep, voffA); PG8_STAGE(PG8_SB(1, 1), cB + hstep + kstep, voffB);
        PG8_WAIT_V(6); PG8_BAR;
    } else {
        PG8_STAGE(PG8_SB(0, 0), cB, voffB); PG8_STAGE(PG8_SA(0, 0), cA, voffA); PG8_STAGE(PG8_SB(0, 1), cB + hstep, voffB); PG8_STAGE(PG8_SA(0, 1), cA + hstep, voffA);
        if (wr == 1) PG8_BAR;
        PG8_WAIT_V(4); PG8_BAR;
        PG8_STAGE(PG8_SB(1, 0), cB + kstep, voffB); PG8_STAGE(PG8_SA(1, 0), cA + kstep, voffA); PG8_STAGE(PG8_SB(1, 1), cB + hstep + kstep, voffB);
        PG8_WAIT_V(6); PG8_BAR;
    }
    for (;;) {
        const bool has_next = S.next(ui + 1, nxt);
        const char* nA = has_next ? (const char*)g.A + (size_t)nxt.pm * tstep : cA; const char* nB = has_next ? (const char*)g.Bt + (size_t)nxt.pn * tstep : cB;
        for (int t = 0; t < nt; t += 2) {
            const bool last = (t == nt - 2);
            const char* a1 = cA + (size_t)(t + 1) * kstep;
            const char* a2 = last ? nA : cA + (size_t)(t + 2) * kstep; const char* b2 = last ? nB : cB + (size_t)(t + 2) * kstep;
            const char* a3 = a2 + kstep; const char* b3 = b2 + kstep;
            if (last && has_next) S.a_ready(nxt);
            if constexpr (SP2) {
            PG8_LDB(B0, 0, 0); PG8_LDB(B1, 0, 1); PG8_SCHED; PG8_LDA(At, 0, 0); PG8_STAGE(PG8_SA(1, 1), a1 + hstep, voffA);
            PG8_WAIT_V(8); PG8_WAIT_L(0); PG8_BAR; PG8_MMA(0, 0, At, B0); PG8_MMA(0, 1, At, B1); PG8_BAR; PG8_SCHED;
            PG8_LDA(At, 0, 1); PG8_STAGE(PG8_SB(0, 0), b2, voffB); PG8_STAGE(PG8_SB(0, 1), b2 + hstep, voffB); PG8_STAGE(PG8_SA(0, 0), a2, voffA);
            PG8_WAIT_V(8); PG8_WAIT_L(0); PG8_BAR; PG8_MMA(1, 0, At, B0); PG8_MMA(1, 1, At, B1); PG8_BAR; PG8_SCHED;
            PG8_LDB(B0, 1, 0); PG8_LDB(B1, 1, 1); PG8_SCHED; PG8_LDA(At, 1, 0); PG8_STAGE(PG8_SA(0, 1), a2 + hstep, voffA);
            PG8_WAIT_V(8); PG8_WAIT_L(0); PG8_BAR; PG8_MMA(0, 0, At, B0); PG8_MMA(0, 1, At, B1); PG8_BAR; PG8_SCHED;
            PG8_LDA(At, 1, 1); PG8_STAGE(PG8_SB(1, 0), b3, voffB); PG8_STAGE(PG8_SB(1, 1), b3 + hstep, voffB); PG8_STAGE(PG8_SA(1, 0), a3, voffA);
            PG8_WAIT_V(8); PG8_WAIT_L(0); PG8_BAR; PG8_MMA(1, 0, At, B0); PG8_MMA(1, 1, At, B1); PG8_BAR; PG8_SCHED;
            } else {
            PG8_LDB(B0, 0, 0); PG8_SCHED; PG8_LDA(At, 0, 0); PG8_STAGE(PG8_SA(1, 1), a1 + hstep, voffA);
            PG8_WAIT_L(8); PG8_BAR; PG8_WAIT_L(0); PG8_MMA(0, 0, At, B0); PG8_BAR; PG8_SCHED;
            PG8_LDB(B1, 0, 1); PG8_STAGE(PG8_SB(0, 0), b2, voffB);
            PG8_BAR; PG8_WAIT_L(0); PG8_MMA(0, 1, At, B1); PG8_BAR;
            PG8_LDA(At, 0, 1); PG8_STAGE(PG8_SA(0, 0), a2, voffA);
            PG8_BAR; PG8_WAIT_L(0); PG8_MMA(1, 0, At, B0); PG8_BAR; PG8_SCHED;
            PG8_STAGE(PG8_SB(0, 1), b2 + hstep, voffB);
            PG8_WAIT_V(6); PG8_BAR; PG8_MMA(1, 1, At, B1); PG8_BAR;
            PG8_LDB(B0, 1, 0); PG8_SCHED; PG8_LDA(At, 1, 0); PG8_STAGE(PG8_SA(0, 1), a2 + hstep, voffA);
            PG8_WAIT_L(8); PG8_BAR; PG8_WAIT_L(0); PG8_MMA(0, 0, At, B0); PG8_BAR; PG8_SCHED;
            PG8_LDB(B1, 1, 1); PG8_STAGE(PG8_SB(1, 0), b3, voffB);
            PG8_BAR; PG8_WAIT_L(0); PG8_MMA(0, 1, At, B1); PG8_BAR;
            PG8_LDA(At, 1, 1); PG8_STAGE(PG8_SA(1, 0), a3, voffA);
            PG8_BAR; PG8_WAIT_L(0); PG8_MMA(1, 0, At, B0); PG8_BAR; PG8_SCHED;
            PG8_STAGE(PG8_SB(1, 1), b3 + hstep, voffB);
            PG8_WAIT_V(6); PG8_BAR; PG8_MMA(1, 1, At, B1); PG8_BAR;
            }
        }
        if constexpr (ALIGN_EPI) { if (wr == 0) PG8_BAR; }
        if constexpr (!Epi::AFTER_DRAIN) { E(acc, cur, wr, wc, fr, fq); S.done(cur); }
        if (!has_next) break;
#pragma unroll
        for (int a = 0; a < 2; ++a)
#pragma unroll
            for (int b = 0; b < 2; ++b)
#pragma unroll
                for (int m = 0; m < 4; ++m)
#pragma unroll
                    for (int n = 0; n < 2; ++n) acc[a][b][m][n] = (f32x4){0.f, 0.f, 0.f, 0.f};
        cur = nxt; cA = nA; cB = nB; ++ui;
        if constexpr (ALIGN_EPI) { if (wr == 1) PG8_BAR; }
    }
    PG8_WAIT_V(0);
    if constexpr (!ALIGN_EPI) { if (wr == 0) PG8_BAR; }
    PG8_BAR;
    if constexpr (Epi::AFTER_DRAIN) { E.fused(acc, cur, wr, wc, fr, fq, lds, wid, lane); S.done(cur); }
#undef PG8_SA
#undef PG8_SB
#undef PG8_STAGE
#undef PG8_LDA
#undef PG8_LDB
#undef PG8_MMA
#undef PG8_WAIT_V
#undef PG8_WAIT_L
#undef PG8_BAR
#undef PG8_SCHED
}
}

#define LAS __attribute__((address_space(3)))
typedef unsigned short bf16_t;
typedef short bf16x8 __attribute__((ext_vector_type(8)));
typedef short s16x4 __attribute__((ext_vector_type(4)));
typedef float f32x4 __attribute__((ext_vector_type(4)));
typedef float f32x16 __attribute__((ext_vector_type(16)));
typedef unsigned u32x2 __attribute__((ext_vector_type(2)));
typedef unsigned u32x4 __attribute__((ext_vector_type(4)));

constexpr int NB = 4, SEQ = 8192, DM = 1024, M = NB * SEQ, INC = 3328, FF = 2816, NH = 8, HD = 64;
constexpr int C_Q = 0, C_K = 512, C_V = 1024, C_RW = 1536, C_R = 1536, C_KR = 2048, C_VR = 2560, C_DW = 3072, C_DA = 3136, C_DG = 3200;
constexpr float ALPHA = 1.189207115002721f;
constexpr float LN_EPS = 1e-5f, GN_EPS = 64e-5f, L2_EPS = 1e-6f;
constexpr float DECAY_SCALE = 0.6065306597126334f;
constexpr float LOG2E = 1.4426950408889634f;
constexpr float QSCALE = 0.125f * LOG2E;
constexpr int NWAVES = 8, NTHREADS = 512;

constexpr size_t MiB = 1u << 20;
constexpr size_t WS_CTL = 0, CTL_ZERO_BYTES = 1 * MiB;
constexpr size_t WS_WIN = 1 * MiB, WS_WOUT = 8 * MiB, WS_WGU = 10 * MiB, WS_WDN = 21 * MiB, WS_CS = 28 * MiB;
constexpr size_t WS_Y = 32 * MiB;
constexpr size_t WS_HID = 32 * MiB;
constexpr size_t WS_TMP5 = 32 * MiB;
constexpr size_t WS_XB = 240 * MiB;
constexpr size_t WS_ATTP = 240 * MiB;
constexpr size_t WS_TMP7 = 240 * MiB;
constexpr size_t WS_LSE = 336 * MiB;
constexpr size_t WS_MIX = 340 * MiB;
constexpr size_t WS_H1B = 404 * MiB;
constexpr size_t WS_END = 502 * MiB;

constexpr int LDS_BYTES = 147456;

__device__ __forceinline__ unsigned f2bf(float f) { unsigned u = __builtin_bit_cast(unsigned, f); return (u + 0x7fffu + ((u >> 16) & 1u)) >> 16; }
__device__ __forceinline__ unsigned pk2(float lo, float hi) { return f2bf(lo) | (f2bf(hi) << 16); }
__device__ __forceinline__ float bf2f(unsigned b) { return __builtin_bit_cast(float, b << 16); }
__device__ __forceinline__ float sigmoidf_(float x) { return 1.f / (1.f + __expf(-x)); }
#define LDS_WAIT() asm volatile("s_waitcnt lgkmcnt(0)" ::: "memory")

struct Args {
    const float* in[22]; const int* pos; float* out; unsigned char* ws; int ph_lo, ph_hi, pad0, pad1;
};
enum { I_X = 0, I_POS = 1, I_WIN = 2, I_WOUT = 3, I_MU = 4, I_W0 = 5, I_WD = 6, I_A0 = 7, I_WA = 8, I_WG = 9, I_KK = 10, I_KA = 11, I_RK = 12, I_GNG = 13, I_GNB = 14,
       I_LN1G = 15, I_LN1B = 16, I_FG = 17, I_FU = 18, I_FD = 19, I_LN2G = 20, I_LN2B = 21 };

__device__ __forceinline__ void p0_transpose_item(const float* W, int K, int N, bf16_t* WT, int dst_row0, LAS float* scr, int k0, int n0, int lane) {
#pragma unroll 8
    for (int i = 0; i < 32; ++i) { const int kk = 2 * i + (lane >> 5); scr[kk * 33 + (lane & 31)] = W[(size_t)(k0 + kk) * N + n0 + (lane & 31)]; }
    LDS_WAIT();
    const int c = lane & 7;
#pragma unroll
    for (int j = 0; j < 4; ++j) { const int n = (lane >> 3) + 8 * j; const LAS float* s = scr + (8 * c) * 33 + n;
        u32x4 o; o.x = pk2(s[0 * 33], s[1 * 33]); o.y = pk2(s[2 * 33], s[3 * 33]); o.z = pk2(s[4 * 33], s[5 * 33]); o.w = pk2(s[6 * 33], s[7 * 33]);
        *(u32x4*)(WT + (size_t)(dst_row0 + n) * K + k0 + 8 * c) = o; }
    LDS_WAIT();
}

__device__ __forceinline__ void sincos_rev(float angf, float& c, float& s) {
    const double a = (double)angf;
    double r = a * 0.15915494309189535; r = r - floor(r); if (r >= 0.5) r -= 1.0;
    const double x = r * 6.283185307179586, x2 = x * x;
    double sc = 1.0, ss = 1.0;
    sc = 1.0; ss = 1.0;
#pragma unroll
    for (int k = 13; k >= 1; --k) { sc = 1.0 - sc * x2 * (1.0 / (double)((2 * k - 1) * (2 * k))); ss = 1.0 - ss * x2 * (1.0 / (double)((2 * k) * (2 * k + 1))); }
    c = (float)sc; s = (float)(ss * x);
}

__device__ __forceinline__ void p0_prologue(const Args& A, LAS unsigned char* lds, int vcu, int G, int tid) {
    const int lane = tid & 63, wave = tid >> 6;
    unsigned char* ws = A.ws;
    LAS float* scr = (LAS float*)(lds + wave * 16384);
    const int gw = vcu * NWAVES + wave, NGW = G * NWAVES;
    constexpr int I_IN = (DM / 64) * (INC / 32), I_OUT = (DM / 64) * (DM / 32), I_G = (DM / 64) * (FF / 32), I_D = (FF / 64) * (DM / 32);
    constexpr int NITEMS = I_IN + I_OUT + 2 * I_G + I_D;
    for (int it = gw; it < NITEMS; it += NGW) {
        int r = it;
        if (r < I_IN) { const int nb = INC / 32, kb = r / nb, n0 = 32 * (r % nb); p0_transpose_item(A.in[I_WIN], DM, INC, (bf16_t*)(ws + WS_WIN), n0, scr, 64 * kb, n0, lane); continue; } r -= I_IN;
        if (r < I_OUT) { const int nb = DM / 32, kb = r / nb, n0 = 32 * (r % nb); p0_transpose_item(A.in[I_WOUT], DM, DM, (bf16_t*)(ws + WS_WOUT), n0, scr, 64 * kb, n0, lane); continue; } r -= I_OUT;
        if (r < 2 * I_G) { const int up = r >= I_G; if (up) r -= I_G; const int nb = FF / 32, kb = r / nb, n0 = 32 * (r % nb);
            p0_transpose_item(A.in[up ? I_FU : I_FG], DM, FF, (bf16_t*)(ws + WS_WGU), 256 * (n0 / 128) + (n0 % 128) + (up ? 128 : 0), scr, 64 * kb, n0, lane); continue; } r -= 2 * I_G;
        { const int nb = DM / 32, kb = r / nb, n0 = 32 * (r % nb); p0_transpose_item(A.in[I_FD], FF, DM, (bf16_t*)(ws + WS_WDN), n0, scr, 64 * kb, n0, lane); }
    }
    { const float* x = A.in[I_X]; bf16_t* xb = (bf16_t*)(ws + WS_XB);
      const size_t n8 = (size_t)M * DM / 8;
      for (size_t i = (size_t)vcu * NTHREADS + tid; i < n8; i += (size_t)G * NTHREADS) {
          const f32x4 a = *(const f32x4*)(x + i * 8), b = *(const f32x4*)(x + i * 8 + 4);
          u32x4 o; o.x = pk2(a[0], a[1]); o.y = pk2(a[2], a[3]); o.z = pk2(b[0], b[1]); o.w = pk2(b[2], b[3]);
          *(u32x4*)(xb + i * 8) = o; } }
    for (int idx = vcu * NTHREADS + tid; idx < 8 * 256 * 8; idx += G * NTHREADS) {
        const int h = idx >> 11, i = (idx >> 3) & 255, c = idx & 7;
        const float* src = (i < 64) ? A.in[I_WD] + (size_t)i * 512 : (i < 128) ? A.in[I_WA] + (size_t)(i - 64) * 512 : A.in[I_WG] + (size_t)(i - 128) * 512;
        const f32x4 a = *(const f32x4*)(src + h * 64 + 8 * c), bq = *(const f32x4*)(src + h * 64 + 8 * c + 4);
        u32x4 o; o.x = pk2(a[0], a[1]); o.y = pk2(a[2], a[3]); o.z = pk2(bq[0], bq[1]); o.w = pk2(bq[2], bq[3]);
        const int row = i & 63, sw = (((row >> 1) & 1) << 1) | (((row >> 3) & 1) << 2);
        *(u32x4*)(ws + (27u << 20) + (size_t)h * 32768 + (i >> 6) * 8192 + row * 128 + ((c ^ sw) << 4)) = o;
    }
    { float* cs = (float*)(ws + WS_CS);
      for (int i = vcu * NTHREADS + tid; i < M * 8; i += G * NTHREADS) {
          const int m = i >> 3, f = i & 7;
          const float invf[8] = {1.0f, 0.1939227432012558f, 0.03760603070259094f, 0.007292664609849453f, 0.0014142135623842478f, 0.00027424818836152554f, 5.318296098266728e-05f, 1.0313386155758053e-05f};
          float fr = invf[0];
#pragma unroll
          for (int q = 1; q < 8; ++q) fr = (f == q) ? invf[q] : fr;
          const float ang = (float)A.pos[m] * fr;
          float c, s; sincos_rev(ang, c, s);
          cs[(size_t)m * 16 + f] = c; cs[(size_t)m * 16 + 8 + f] = s; } }
}

__device__ __forceinline__ int crow(int r, int hi) { return (r & 3) + 8 * (r >> 2) + 4 * hi; }
typedef short v4i16_t __attribute__((ext_vector_type(4)));
__device__ __forceinline__ s16x4 vtr(const LAS unsigned char* p) { return __builtin_bit_cast(s16x4, __builtin_amdgcn_ds_read_tr16_b64_v4i16((LAS v4i16_t*)p)); }

constexpr int ATT_KROWS = 384;
constexpr int ATT_LK = 0, ATT_LV = ATT_KROWS * 128, ATT_LW = 2 * ATT_KROWS * 128, ATT_WSCR = 4096 + 256;

__device__ __forceinline__ void attn_partial_phase(LAS unsigned char* lds, const bf16_t* Y, bf16_t* OP, float* LSE, int vcu, int G, int tid) {
    const int lane = tid & 63, wid = __builtin_amdgcn_readfirstlane(tid >> 6), r32 = lane & 31, hi = lane >> 5;
    LAS unsigned char* Kimg = lds + ATT_LK; LAS unsigned char* Vimg = lds + ATT_LV;
    LAS unsigned char* wscr = lds + ATT_LW + wid * ATT_WSCR;
    LAS float* wsf = (LAS float*)(wscr + 4096);
    for (int unit = vcu; unit < 32 * 96; unit += G) {
        const int bh = unit / 96, rem = unit % 96, p = rem >> 5, j = rem & 31;
        const int b = bh >> 3, h = bh & 7;
        const int dl = 2 * p, d = 1 << dl;
        const int nblk = 32 >> dl;
        const int rcls = j / nblk, i0 = (j % nblk) * 256;
        const size_t rowb = (size_t)b * SEQ;
        for (int idx = tid; idx < ATT_KROWS * 8; idx += NTHREADS) {
            const int row = idx >> 3, ch = idx & 7, ci = i0 - 128 + row;
            u32x4 kv = {0u, 0u, 0u, 0u}, vv = kv;
            if (ci >= 0) { const bf16_t* pp = Y + (rowb + (size_t)ci * d + rcls) * INC + h * HD + ch * 8; kv = *(const u32x4*)(pp + C_K); vv = *(const u32x4*)(pp + C_V); }
            *(LAS u32x4*)(Kimg + row * 128 + ((ch ^ ((row >> 1) & 7)) << 4)) = kv;
            *(LAS u32x4*)(Vimg + row * 128 + ((ch ^ (((row >> 1) & 1) << 2)) << 4)) = vv;
        }
        __syncthreads();
        const int qidx = i0 + 32 * wid + r32;
        const bf16_t* qptr = Y + (rowb + (size_t)qidx * d + rcls) * INC + C_Q + h * HD;
        bf16x8 qf[4];
#pragma unroll
        for (int d0 = 0; d0 < 4; ++d0) qf[d0] = *(const bf16x8*)(qptr + 16 * d0 + 8 * hi);
        f32x16 pt[5];
#pragma unroll
        for (int kt = 0; kt < 5; ++kt) {
            f32x16 acc = {};
            const int row = 32 * wid + 32 * kt + r32;
#pragma unroll
            for (int d0 = 0; d0 < 4; ++d0) {
                const int ch = 2 * d0 + hi;
                const bf16x8 kf = *(const LAS bf16x8*)(Kimg + row * 128 + ((ch ^ ((row >> 1) & 7)) << 4));
                acc = __builtin_amdgcn_mfma_f32_32x32x16_bf16(kf, qf[d0], acc, 0, 0, 0);
            }
            pt[kt] = acc;
        }
        float mx = -INFINITY;
#pragma unroll
        for (int kt = 0; kt < 5; ++kt)
#pragma unroll
            for (int r = 0; r < 16; ++r) {
                const int cr = crow(r, hi);
                const int delta = 128 - 32 * kt + r32 - cr;
                const int kidx = i0 - 128 + 32 * wid + 32 * kt + cr;
                const bool valid = (delta >= 0) && (delta <= 128) && (kidx >= 0);
                float v = pt[kt][r]; v = valid ? v : -INFINITY; pt[kt][r] = v; mx = fmaxf(mx, v);
            }
        mx = fmaxf(mx, __shfl_xor(mx, 32));
        float l = 0.f;
#pragma unroll
        for (int kt = 0; kt < 5; ++kt)
#pragma unroll
            for (int r = 0; r < 16; ++r) { const float e = __builtin_amdgcn_exp2f(pt[kt][r] - mx); pt[kt][r] = e; l += e; }
        l += __shfl_xor(l, 32);
        f32x16 o[2]; o[0] = f32x16{}; o[1] = f32x16{};
        const int g1 = (lane >> 4) & 1, q4 = (lane & 15) >> 2, p4 = lane & 3;
#pragma unroll
        for (int kt = 0; kt < 5; ++kt)
#pragma unroll
            for (int s = 0; s < 2; ++s) {
                u32x4 pw;
                pw.x = pk2(pt[kt][8 * s + 0], pt[kt][8 * s + 1]); pw.y = pk2(pt[kt][8 * s + 2], pt[kt][8 * s + 3]);
                pw.z = pk2(pt[kt][8 * s + 4], pt[kt][8 * s + 5]); pw.w = pk2(pt[kt][8 * s + 6], pt[kt][8 * s + 7]);
                const bf16x8 pa = __builtin_bit_cast(bf16x8, pw);
                const int rlo = 32 * wid + 32 * kt + 16 * s + 4 * hi + q4, rhi = rlo + 8;
#pragma unroll
                for (int dh = 0; dh < 2; ++dh) {
                    const int chunk = 4 * dh + 2 * g1 + (p4 >> 1), sub = 8 * (p4 & 1);
                    const s16x4 vlo = vtr(Vimg + rlo * 128 + ((chunk ^ (((rlo >> 1) & 1) << 2)) << 4) + sub);
                    const s16x4 vhi = vtr(Vimg + rhi * 128 + ((chunk ^ (((rhi >> 1) & 1) << 2)) << 4) + sub);
                    const bf16x8 vf = (bf16x8){vlo[0], vlo[1], vlo[2], vlo[3], vhi[0], vhi[1], vhi[2], vhi[3]};
                    o[dh] = __builtin_amdgcn_mfma_f32_32x32x16_bf16(pa, vf, o[dh], 0, 0, 0);
                }
            }
        if (hi == 0) wsf[r32] = l;
        LDS_WAIT();
        bf16_t LAS* stg = (bf16_t LAS*)wscr;
#pragma unroll
        for (int r = 0; r < 16; ++r) {
            const int q = crow(r, hi); const float rl = 1.f / wsf[q];
            stg[q * 64 + r32] = (bf16_t)f2bf(o[0][r] * rl); stg[q * 64 + 32 + r32] = (bf16_t)f2bf(o[1][r] * rl);
        }
        LDS_WAIT();
        bf16_t* OPp = OP + (size_t)p * M * 512;
#pragma unroll
        for (int i = 0; i < 4; ++i) {
            const int q = i * 8 + (lane >> 3), ch = lane & 7;
            const u32x4 v = *(const LAS u32x4*)(wscr + q * 128 + ch * 16);
            const size_t tok = rowb + (size_t)(i0 + 32 * wid + q) * d + rcls;
            *(u32x4*)(OPp + tok * 512 + h * HD + ch * 8) = v;
        }
        if (hi == 0) { const size_t tok = rowb + (size_t)qidx * d + rcls; LSE[(size_t)p * M * 8 + tok * 8 + h] = mx + __log2f(l); }
        __syncthreads();
    }
}

__device__ __forceinline__ void attn_merge_phase(const bf16_t* OP, const float* LSE, bf16_t* MIX, int vcu, int G, int tid) {
    const size_t total = (size_t)M * 64;
    for (size_t i = (size_t)vcu * NTHREADS + tid; i < total; i += (size_t)G * NTHREADS) {
        const size_t tok = i >> 6; const int hc = (int)(i & 63), h = hc >> 3;
        const float l0 = LSE[tok * 8 + h], l1 = LSE[(size_t)M * 8 + tok * 8 + h], l2 = LSE[(size_t)2 * M * 8 + tok * 8 + h];
        const float mx = fmaxf(l0, fmaxf(l1, l2));
        float w0 = __builtin_amdgcn_exp2f(l0 - mx), w1 = __builtin_amdgcn_exp2f(l1 - mx), w2 = __builtin_amdgcn_exp2f(l2 - mx);
        const float inv = 1.f / (w0 + w1 + w2); w0 *= inv; w1 *= inv; w2 *= inv;
        const u32x4 a = *(const u32x4*)(OP + tok * 512 + hc * 8), bq = *(const u32x4*)(OP + (size_t)M * 512 + tok * 512 + hc * 8), c = *(const u32x4*)(OP + (size_t)2 * M * 512 + tok * 512 + hc * 8);
        u32x4 o;
#pragma unroll
        for (int e = 0; e < 4; ++e) {
            const float lo = w0 * bf2f(a[e] & 0xffffu) + w1 * bf2f(bq[e] & 0xffffu) + w2 * bf2f(c[e] & 0xffffu);
            const float hi = w0 * bf2f(a[e] >> 16) + w1 * bf2f(bq[e] >> 16) + w2 * bf2f(c[e] >> 16);
            o[e] = pk2(lo, hi);
        }
        *(u32x4*)(MIX + tok * DM + hc * 8) = o;
    }
}

__device__ __forceinline__ float ysh(const bf16_t* Y, size_t row, int t, int col, const float* mu) {
    const float yc = bf2f(Y[row * INC + col]); const float yp = (t > 0) ? bf2f(Y[(row - 1) * INC + col]) : 0.f;
    return yc + mu[col - C_RW] * (yp - yc);
}
__device__ __forceinline__ void rwkv_direct_phase(LAS unsigned char* lds, const Args& A, const bf16_t* Y, bf16_t* MIX, int vcu, int tid) {
    if (vcu >= 32) return;
    const int b = vcu >> 3, h = vcu & 7;
    LAS float* LIN = (LAS float*)lds;
    LAS float* RR = LIN + 32 * 256;
    LAS float* WW = RR + 2048; LAS float* KM = WW + 2048; LAS float* VV = KM + 2048; LAS float* AV = VV + 2048; LAS float* BV = AV + 2048; LAS float* GG = BV + 2048; LAS float* OB = GG + 2048;
    LAS float* BON = OB + 2048;
    const float* mu = A.in[I_MU];
    float s[8];
#pragma unroll
    for (int i = 0; i < 8; ++i) s[i] = 0.f;
#pragma unroll 1
    for (int ci = 0; ci < SEQ / 32; ++ci) {
        const int t0 = ci * 32; const size_t row0 = (size_t)b * SEQ + t0;
        for (int idx = tid; idx < 32 * 256; idx += NTHREADS) {
            const int tok = idx >> 8, c = idx & 255;
            float v = ysh(Y, row0 + tok, t0 + tok, C_DW + c, mu);
            if (c < 64) v = tanhf(v); else if (c >= 128) v = sigmoidf_(v);
            LIN[idx] = v;
        }
        __syncthreads();
        {
            const int tok = tid >> 4, jg = tid & 15, j0 = 4 * jg, cj = h * 64 + j0;
            float wl[4], al[4], gl[4];
#pragma unroll
            for (int e = 0; e < 4; ++e) { wl[e] = A.in[I_W0][cj + e]; al[e] = A.in[I_A0][cj + e]; gl[e] = 0.f; }
            const LAS float* li = LIN + tok * 256;
#pragma unroll 2
            for (int i = 0; i < 64; ++i) {
                const f32x4 wd = *(const f32x4*)(A.in[I_WD] + (size_t)i * 512 + cj), wa = *(const f32x4*)(A.in[I_WA] + (size_t)i * 512 + cj);
                const float x1 = li[i], x2 = li[64 + i];
#pragma unroll
                for (int e = 0; e < 4; ++e) { wl[e] += x1 * wd[e]; al[e] += x2 * wa[e]; }
            }
#pragma unroll 2
            for (int i = 0; i < 128; ++i) {
                const f32x4 wg = *(const f32x4*)(A.in[I_WG] + (size_t)i * 512 + cj); const float x3 = li[128 + i];
#pragma unroll
                for (int e = 0; e < 4; ++e) gl[e] += x3 * wg[e];
            }
            float r[4], kr[4], vr[4], kk[4]; float n2 = 0.f;
#pragma unroll
            for (int e = 0; e < 4; ++e) {
                r[e] = ysh(Y, row0 + tok, t0 + tok, C_R + cj + e, mu); kr[e] = ysh(Y, row0 + tok, t0 + tok, C_KR + cj + e, mu); vr[e] = ysh(Y, row0 + tok, t0 + tok, C_VR + cj + e, mu);
                kk[e] = kr[e] * A.in[I_KK][cj + e]; n2 += kk[e] * kk[e];
            }
            n2 += __shfl_xor(n2, 1); n2 += __shfl_xor(n2, 2); n2 += __shfl_xor(n2, 4); n2 += __shfl_xor(n2, 8);
            const float inv = 1.f / fmaxf(sqrtf(n2), L2_EPS);
            float bon = 0.f;
#pragma unroll
            for (int e = 0; e < 4; ++e) {
                const float a = sigmoidf_(al[e]); const float dec = __expf(-DECAY_SCALE * sigmoidf_(wl[e]));
                const float kn = kk[e] * inv; const float km = kr[e] * (1.f + (a - 1.f) * A.in[I_KA][cj + e]);
                bon += r[e] * km * A.in[I_RK][cj + e];
                const int o = tok * 64 + j0 + e;
                RR[o] = r[e]; WW[o] = dec; KM[o] = km; VV[o] = vr[e]; AV[o] = -kn; BV[o] = kn * a; GG[o] = gl[e];
            }
            bon += __shfl_xor(bon, 1); bon += __shfl_xor(bon, 2); bon += __shfl_xor(bon, 4); bon += __shfl_xor(bon, 8);
            if (jg == 0) BON[tok] = bon;
        }
        __syncthreads();
        {
            const int v = tid >> 3, kq = tid & 7;
#pragma unroll 1
            for (int t = 0; t < 32; ++t) {
                const int o = t * 64 + 8 * kq;
                const f32x4 a0 = *(const LAS f32x4*)(AV + o), a1 = *(const LAS f32x4*)(AV + o + 4), w0 = *(const LAS f32x4*)(WW + o), w1 = *(const LAS f32x4*)(WW + o + 4);
                const f32x4 b0 = *(const LAS f32x4*)(BV + o), b1 = *(const LAS f32x4*)(BV + o + 4), k0 = *(const LAS f32x4*)(KM + o), k1 = *(const LAS f32x4*)(KM + o + 4);
                const f32x4 r0 = *(const LAS f32x4*)(RR + o), r1 = *(const LAS f32x4*)(RR + o + 4);
                const float vv = VV[t * 64 + v];
                float sa = 0.f;
#pragma unroll
                for (int e = 0; e < 4; ++e) sa += s[e] * a0[e] + s[4 + e] * a1[e];
                sa += __shfl_xor(sa, 1); sa += __shfl_xor(sa, 2); sa += __shfl_xor(sa, 4);
                float oo = 0.f;
#pragma unroll
                for (int e = 0; e < 4; ++e) {
                    s[e] = s[e] * w0[e] + sa * b0[e] + vv * k0[e]; s[4 + e] = s[4 + e] * w1[e] + sa * b1[e] + vv * k1[e];
                    oo += s[e] * r0[e] + s[4 + e] * r1[e];
                }
                oo += __shfl_xor(oo, 1); oo += __shfl_xor(oo, 2); oo += __shfl_xor(oo, 4);
                if (kq == 0) OB[t * 64 + v] = oo;
            }
        }
        __syncthreads();
        {
            const int tok = tid >> 4, jg = tid & 15, v0 = 4 * jg;
            float ov[4], sm = 0.f;
#pragma unroll
            for (int e = 0; e < 4; ++e) { ov[e] = OB[tok * 64 + v0 + e]; sm += ov[e]; }
            sm += __shfl_xor(sm, 1); sm += __shfl_xor(sm, 2); sm += __shfl_xor(sm, 4); sm += __shfl_xor(sm, 8);
            const float mean = sm * (1.f / 64.f); float q = 0.f;
#pragma unroll
            for (int e = 0; e < 4; ++e) { const float dlt = ov[e] - mean; q += dlt * dlt; }
            q += __shfl_xor(q, 1); q += __shfl_xor(q, 2); q += __shfl_xor(q, 4); q += __shfl_xor(q, 8);
            const float rstd = 1.f / sqrtf(q * (1.f / 64.f) + GN_EPS);
            const float bon = BON[tok];
            float res[4];
#pragma unroll
            for (int e = 0; e < 4; ++e) { const int cj = h * 64 + v0 + e;
                const float on = (ov[e] - mean) * rstd * A.in[I_GNG][cj] + A.in[I_GNB][cj];
                res[e] = (on + bon * VV[tok * 64 + v0 + e]) * GG[tok * 64 + v0 + e]; }
            u32x2 w; w.x = pk2(res[0], res[1]); w.y = pk2(res[2], res[3]);
            *(u32x2*)(MIX + (row0 + tok) * DM + 512 + h * 64 + v0) = w;
        }
    }
}

__device__ __forceinline__ float wave_sum(float v) {
#pragma unroll
    for (int o = 1; o < 64; o <<= 1) v += __shfl_xor(v, o);
    return v;
}
__device__ __forceinline__ void ln_rows_phase(const float* in, const float* g, const float* bta, float* outf, bf16_t* outb, int vcu, int G, int tid) {
    const int lane = tid & 63, wave = tid >> 6;
    f32x4 gv[4], bv[4];
#pragma unroll
    for (int j = 0; j < 4; ++j) { gv[j] = *(const f32x4*)(g + 4 * lane + 256 * j); bv[j] = *(const f32x4*)(bta + 4 * lane + 256 * j); }
    for (int m = vcu * NWAVES + wave; m < M; m += G * NWAVES) {
        const f32x4* xr = (const f32x4*)(in + (size_t)m * DM) + lane;
        f32x4 v[4]; float s = 0.f;
#pragma unroll
        for (int j = 0; j < 4; ++j) { v[j] = xr[64 * j]; s += (v[j][0] + v[j][1]) + (v[j][2] + v[j][3]); }
        const float mean = wave_sum(s) * (1.f / DM); float s2 = 0.f;
#pragma unroll
        for (int j = 0; j < 4; ++j) { v[j] = v[j] - mean; s2 += (v[j][0] * v[j][0] + v[j][1] * v[j][1]) + (v[j][2] * v[j][2] + v[j][3] * v[j][3]); }
        const float rstd = 1.f / sqrtf(wave_sum(s2) * (1.f / DM) + LN_EPS);
#pragma unroll
        for (int j = 0; j < 4; ++j) {
            const f32x4 o = v[j] * rstd * gv[j] + bv[j];
            *((f32x4*)(outf + (size_t)m * DM) + lane + 64 * j) = o;
            if (outb) { u32x2 w; w.x = pk2(o[0], o[1]); w.y = pk2(o[2], o[3]); *((u32x2*)(outb + (size_t)m * DM) + lane + 64 * j) = w; }
        }
    }
}


constexpr int RW_SLOT = 8192;
constexpr int RW_SEG = 16 * RW_SLOT, RW_DG = RW_SEG + 2048, RW_BON = RW_DG + 256, RW_CONST = RW_BON + 256;
constexpr size_t WS_LORA = 27 * MiB;
constexpr size_t WS_RWET = 404 * MiB, WS_RWFI = 436 * MiB, WS_RWGG = 468 * MiB, WS_RWBON = 500 * MiB;
constexpr size_t WS_RWPT = 0;
constexpr size_t WS_RWQT = 32 * MiB;
constexpr size_t WS_RWS0 = 96 * MiB;

__device__ __forceinline__ int rw_swz(int row) { return (((row >> 1) & 1) << 1) | (((row >> 3) & 1) << 2); }
__device__ __forceinline__ int rw_off(int row, int chunk) { return row * 128 + ((chunk ^ rw_swz(row)) << 4); }
typedef float f32x2v __attribute__((ext_vector_type(2)));

template <int COL> __device__ __forceinline__ bf16x8 rw_frag(const LAS unsigned char* img, int u0, int s0, int fr, int fq) {
    if (COL == 0) {
        return *(const LAS bf16x8*)(img + rw_off(u0 + fr, (s0 >> 3) + fq));
    } else {
        const int rlo = s0 + 8 * fq + (fr >> 2), rhi = rlo + 4, p = fr & 3, ch = (u0 >> 3) + (p >> 1), sub = 8 * (p & 1);
        const s16x4 lo = vtr(img + rw_off(rlo, ch) + sub), hi = vtr(img + rw_off(rhi, ch) + sub);
        return (bf16x8){lo[0], lo[1], lo[2], lo[3], hi[0], hi[1], hi[2], hi[3]};
    }
}
template <int FCOL, int SCOL, int NPT> __device__ __forceinline__ void rw_mm(f32x4 (&acc)[NPT], const LAS unsigned char* imgF, const LAS unsigned char* imgS, int p0, int q0, int fr, int fq) {
#pragma unroll
    for (int ks = 0; ks < 2; ++ks) {
        const bf16x8 sf = rw_frag<SCOL>(imgS, q0, 32 * ks, fr, fq);
#pragma unroll
        for (int pt = 0; pt < NPT; ++pt) { const bf16x8 ff = rw_frag<FCOL>(imgF, p0 + 16 * pt, 32 * ks, fr, fq); acc[pt] = __builtin_amdgcn_mfma_f32_16x16x32_bf16(ff, sf, acc[pt], 0, 0, 0); }
    }
}
__device__ __forceinline__ void rw_store4(LAS unsigned char* img, int q, int p, f32x4 v) {
    u32x2 w; w.x = pk2(v[0], v[1]); w.y = pk2(v[2], v[3]);
    *(LAS u32x2*)(img + rw_off(q, p >> 3) + (p & 7) * 2) = w;
}
__device__ __forceinline__ f32x4 rw_load4(const LAS unsigned char* img, int q, int p) {
    const u32x2 w = *(const LAS u32x2*)(img + rw_off(q, p >> 3) + (p & 7) * 2);
    return (f32x4){bf2f(w.x & 0xffffu), bf2f(w.x >> 16), bf2f(w.y & 0xffffu), bf2f(w.y >> 16)};
}


__device__ __forceinline__ void rw_load_consts(LAS float* CH, const Args& A, int h, int tid) {
    const float* mu = A.in[I_MU];
    for (int i = tid; i < 768; i += NTHREADS) {
        float v;
        if (i < 192) v = mu[(i >> 6) * 512 + h * 64 + (i & 63)];
        else if (i < 448) v = mu[(C_DW - C_RW) + (i - 192)];
        else { const int w = (i - 448) >> 6, j = (i - 448) & 63; const float* src = (w == 0) ? A.in[I_KK] : (w == 1) ? A.in[I_KA] : (w == 2) ? A.in[I_RK] : (w == 3) ? A.in[I_W0] : A.in[I_A0]; v = src[h * 64 + j]; }
        CH[i] = v;
    }
}
struct RwRaw { u32x4 lin[4][2]; u32x4 kvr[3][2]; };
__device__ __forceinline__ void rw_issue_lin(RwRaw& R, const bf16_t* Y, size_t row0, int t0, int tid) {
#pragma unroll
    for (int n = 0; n < 4; ++n) {
        const int it = tid + NTHREADS * n, t = it >> 5, c = it & 31;
        const bf16_t* yc = Y + (row0 + t) * INC + C_DW + 8 * c;
        R.lin[n][0] = *(const u32x4*)yc; R.lin[n][1] = (t0 + t > 0) ? *(const u32x4*)(yc - INC) : (u32x4){0u, 0u, 0u, 0u};
    }
}
__device__ __forceinline__ void rw_issue_kvr(RwRaw& R, const bf16_t* Y, size_t row0, int t0, int h, int tid) {
    const int t = tid >> 3, jg = tid & 7;
    const bf16_t* yr = Y + (row0 + t) * INC + h * 64 + 8 * jg;
#pragma unroll
    for (int w = 0; w < 3; ++w) { R.kvr[w][0] = *(const u32x4*)(yr + C_R + 512 * w); R.kvr[w][1] = (t0 + t > 0) ? *(const u32x4*)(yr + C_R + 512 * w - INC) : (u32x4){0u, 0u, 0u, 0u}; }
}
#define BFLO(w) bf2f((w) & 0xffffu)
#define BFHI(w) bf2f((w) >> 16)

__device__ __forceinline__ void rwkv_prep_phase(LAS unsigned char* lds, const Args& A, const bf16_t* Y, unsigned char* scr  , int vcu, int G, int tid) {
    const int lane = tid & 63, wid = __builtin_amdgcn_readfirstlane(tid >> 6);
    int fr = lane & 15, fq = lane >> 4;
    const int wr = wid & 3, wc = wid >> 2, q0 = 16 * wr, p0 = 32 * wc;
#define RELAUNDER() asm volatile("" : "+v"(fr), "+v"(fq))
#define SLOT(i) (lds + (i) * RW_SLOT)
    LAS unsigned char* const GGi = SLOT(0);
    LAS unsigned char* const ATi = SLOT(1); LAS unsigned char* const BTi = SLOT(2); LAS unsigned char* const KTi = SLOT(3); LAS unsigned char* const RTi = SLOT(4);
    LAS unsigned char* const BHi = SLOT(5); LAS unsigned char* const KHi = SLOT(6); LAS unsigned char* const VTi = SLOT(7);
    LAS unsigned char* const WDi = SLOT(1); LAS unsigned char* const WAi = SLOT(2); LAS unsigned char* const WG0i = SLOT(3); LAS unsigned char* const WG1i = SLOT(4);
    LAS unsigned char* const TDi = SLOT(5); LAS unsigned char* const DAi = SLOT(6); LAS unsigned char* const SG0i = SLOT(7); LAS unsigned char* const SG1i = SLOT(8);
    LAS float* const LW = (LAS float*)SLOT(9);
    LAS float* const AA = (LAS float*)SLOT(11);
    LAS unsigned char* const NABi = SLOT(8); LAS unsigned char* const NAKi = SLOT(9); LAS unsigned char* const MBRi = SLOT(10); LAS unsigned char* const MKRi = SLOT(11);
    LAS unsigned char* const NIa = SLOT(12); LAS unsigned char* const NIb = SLOT(13); LAS unsigned char* const TPa = SLOT(14); LAS unsigned char* const TPb = SLOT(15);
    LAS unsigned char* const XMi = SLOT(2); LAS unsigned char* const YKi = SLOT(3);
    LAS unsigned char* const ZIi = SLOT(12); LAS unsigned char* const ETi = SLOT(13); LAS unsigned char* const FIi = SLOT(15);
    LAS float* const SEG = (LAS float*)(lds + RW_SEG);
    LAS float* const DG = (LAS float*)(lds + RW_DG);
    LAS float* const BON = (LAS float*)(lds + RW_BON);
    LAS float* const CH = (LAS float*)(lds + RW_CONST);
    LAS float* const MUH = CH; LAS float* const KKH = CH + 448; LAS float* const KAH = CH + 512; LAS float* const RKH = CH + 576; LAS float* const W0H = CH + 640; LAS float* const A0H = CH + 704;
    int hcur = -1;
    u32x4 wreg[4];
    RwRaw R;
#define ITEM_CHAIN(it) (((it) >> 3) & 31)
#define ITEM_CI(it) (((it) & 7) + 8 * ((it) >> 8))
    if (vcu < 4096) { const int chain = ITEM_CHAIN(vcu), ci = ITEM_CI(vcu); rw_issue_lin(R, Y, (size_t)(chain >> 3) * SEQ + ci * 64, ci * 64, tid); }
    for (int item = vcu; item < 4096; item += G) {
        const int chain = ITEM_CHAIN(item), ci = ITEM_CI(item);
        const int b = chain >> 3, h = chain & 7, t0 = ci * 64, cid = chain * 128 + ci;
        int tl = tid; asm volatile("" : "+v"(tl));
        const size_t row0 = (size_t)b * SEQ + t0;
        if (h != hcur) {
            __syncthreads();
            rw_load_consts(CH, A, h, tl);
            const unsigned char* lw = A.ws + WS_LORA + (size_t)h * 32768;
#pragma unroll
            for (int n = 0; n < 4; ++n) wreg[n] = *(const u32x4*)(lw + (size_t)(tl + NTHREADS * n) * 16);
            hcur = h;
            __syncthreads();
        }
        rw_issue_kvr(R, Y, row0, t0, h, tl);
#pragma unroll
        for (int n = 0; n < 4; ++n) *(LAS u32x4*)(SLOT(1) + (tl + NTHREADS * n) * 16) = wreg[n];
#pragma unroll
        for (int n = 0; n < 4; ++n) {
            const int it = tl + NTHREADS * n, t = it >> 5, c = it & 31;
            const u32x4 cur = R.lin[n][0], prv = R.lin[n][1];
            float v[8];
#pragma unroll
            for (int e = 0; e < 4; ++e) {
                const float c0 = BFLO(cur[e]), c1 = BFHI(cur[e]), q0_ = BFLO(prv[e]), q1_ = BFHI(prv[e]);
                v[2 * e] = c0 + MUH[192 + 8 * c + 2 * e] * (q0_ - c0); v[2 * e + 1] = c1 + MUH[192 + 8 * c + 2 * e + 1] * (q1_ - c1);
            }
            if (c < 8) {
#pragma unroll
                for (int e = 0; e < 8; ++e) { const float ex = __expf(2.f * v[e]); v[e] = 1.f - 2.f / (ex + 1.f); }
            } else if (c >= 16) {
#pragma unroll
                for (int e = 0; e < 8; ++e) v[e] = sigmoidf_(v[e]);
            }
            u32x4 o; o.x = pk2(v[0], v[1]); o.y = pk2(v[2], v[3]); o.z = pk2(v[4], v[5]); o.w = pk2(v[6], v[7]);
            *(LAS u32x4*)(SLOT(5 + (c >> 3)) + rw_off(t, c & 7)) = o;
        }
        __syncthreads();
        RELAUNDER();
        {
            f32x4 aw[2] = {}, aa[2] = {}, ag[2] = {};
            rw_mm<1, 0, 2>(aw, WDi, TDi, p0, q0, fr, fq);
            rw_mm<1, 0, 2>(aa, WAi, DAi, p0, q0, fr, fq);
            rw_mm<1, 0, 2>(ag, WG0i, SG0i, p0, q0, fr, fq);
            rw_mm<1, 0, 2>(ag, WG1i, SG1i, p0, q0, fr, fq);
            const int t = q0 + fr;
#pragma unroll
            for (int pt = 0; pt < 2; ++pt) {
                const int j = p0 + 16 * pt + 4 * fq;
                const f32x4 w0v = *(const LAS f32x4*)(W0H + j), a0v = *(const LAS f32x4*)(A0H + j);
                f32x4 lw, av;
#pragma unroll
                for (int e = 0; e < 4; ++e) { lw[e] = -DECAY_SCALE * sigmoidf_(aw[pt][e] + w0v[e]); av[e] = sigmoidf_(aa[pt][e] + a0v[e]); }
                *(LAS f32x4*)(LW + t * 64 + j) = lw; *(LAS f32x4*)(AA + t * 64 + j) = av;
                rw_store4(GGi, t, j, ag[pt]);
            }
        }
        __syncthreads();
        {
            const int j = tl & 63, seg = tl >> 6; float acc = 0.f;
#pragma unroll
            for (int i = 0; i < 8; ++i) { const int t = 8 * seg + i; acc += LW[t * 64 + j]; LW[t * 64 + j] = acc; }
            SEG[seg * 64 + j] = acc;
        }
        __syncthreads();
        {
            int t = tl >> 3, jg = tl & 7; asm volatile("" : "+v"(t), "+v"(jg));
            const int j0 = 8 * jg, seg = t >> 3;
            const u32x4 rcur = R.kvr[0][0], rprv = R.kvr[0][1], kcur = R.kvr[1][0], kprv = R.kvr[1][1], vcur = R.kvr[2][0], vprv = R.kvr[2][1];
            float n2 = 0.f;
#pragma unroll
            for (int e = 0; e < 8; ++e) {
                const unsigned cw = kcur[e >> 1], pw = kprv[e >> 1];
                const float c = (e & 1) ? BFHI(cw) : BFLO(cw), q = (e & 1) ? BFHI(pw) : BFLO(pw);
                const float x = c + MUH[64 + j0 + e] * (q - c);
                const float kk = x * KKH[j0 + e]; n2 += kk * kk;
            }
            n2 += __shfl_xor(n2, 1); n2 += __shfl_xor(n2, 2); n2 += __shfl_xor(n2, 4);
            const float inv = 1.f / fmaxf(sqrtf(n2), L2_EPS);
            u32x4 pat, pbt, pkt, prt, pbh, pkh, pvt; float bon = 0.f;
#pragma unroll
            for (int e2 = 0; e2 < 4; ++e2) {
                float at[2], bt[2], kt[2], rt[2], bh[2], kh[2], vv[2];
#pragma unroll
                for (int u = 0; u < 2; ++u) {
                    const int e = 2 * e2 + u, j = j0 + e;
                    const float kc = u ? BFHI(kcur[e2]) : BFLO(kcur[e2]), kq = u ? BFHI(kprv[e2]) : BFLO(kprv[e2]);
                    const float rc = u ? BFHI(rcur[e2]) : BFLO(rcur[e2]), rq = u ? BFHI(rprv[e2]) : BFLO(rprv[e2]);
                    const float vc = u ? BFHI(vcur[e2]) : BFLO(vcur[e2]), vq = u ? BFHI(vprv[e2]) : BFLO(vprv[e2]);
                    const float kr = kc + MUH[64 + j] * (kq - kc), r = rc + MUH[j] * (rq - rc), vr = vc + MUH[128 + j] * (vq - vc);
                    float pre = 0.f, gc = 0.f;
#pragma unroll
                    for (int sgi = 0; sgi < 8; ++sgi) { const float sv = SEG[sgi * 64 + j]; gc += sv; pre += (sgi < seg) ? sv : 0.f; }
                    const float gp = LW[t * 64 + j], gprev = (t & 7) ? LW[(t - 1) * 64 + j] : 0.f;
                    const float gt = gp + pre, gm1 = gprev + pre;
                    const float a = AA[t * 64 + j];
                    const float kn = kr * KKH[j] * inv, km = kr * (1.f + (a - 1.f) * KAH[j]);
                    const float bvv = kn * a;
                    const float eg = __expf(gt), egm1 = __expf(gm1), eng = __expf(-gt), egc = __expf(gc - gt);
                    at[u] = -kn * egm1; rt[u] = r * eg; bt[u] = bvv * eng; kt[u] = km * eng; bh[u] = bvv * egc; kh[u] = km * egc; vv[u] = vr;
                    bon += r * km * RKH[j];
                    if (t == 63) DG[j] = __expf(gc);
                }
                pat[e2] = pk2(at[0], at[1]); pbt[e2] = pk2(bt[0], bt[1]); pkt[e2] = pk2(kt[0], kt[1]); prt[e2] = pk2(rt[0], rt[1]);
                pbh[e2] = pk2(bh[0], bh[1]); pkh[e2] = pk2(kh[0], kh[1]); pvt[e2] = pk2(vv[0], vv[1]);
            }
            bon += __shfl_xor(bon, 1); bon += __shfl_xor(bon, 2); bon += __shfl_xor(bon, 4);
            if (jg == 0) BON[t] = bon;
            const int off = rw_off(t, jg);
            *(LAS u32x4*)(ATi + off) = pat; *(LAS u32x4*)(BTi + off) = pbt; *(LAS u32x4*)(KTi + off) = pkt; *(LAS u32x4*)(RTi + off) = prt;
            *(LAS u32x4*)(BHi + off) = pbh; *(LAS u32x4*)(KHi + off) = pkh; *(LAS u32x4*)(VTi + off) = pvt;
        }
        { const int nitem = item + G; if (nitem < 4096) { const int nchain = ITEM_CHAIN(nitem), nci = ITEM_CI(nitem); rw_issue_lin(R, Y, (size_t)(nchain >> 3) * SEQ + nci * 64, nci * 64, tl); } }
        __syncthreads();
        RELAUNDER();
        f32x4 tp[2], ni[2];
        {
            f32x4 nab[2] = {}, nak[2] = {}, mbr[2] = {}, mkr[2] = {};
            rw_mm<0, 0, 2>(nab, ATi, BTi, p0, q0, fr, fq);
            rw_mm<0, 0, 2>(nak, ATi, KTi, p0, q0, fr, fq);
            rw_mm<0, 0, 2>(mbr, RTi, BTi, p0, q0, fr, fq);
            rw_mm<0, 0, 2>(mkr, RTi, KTi, p0, q0, fr, fq);
            const int jrow = q0 + fr;
#pragma unroll
            for (int pt = 0; pt < 2; ++pt) {
                const int tc = p0 + 16 * pt + 4 * fq;
#pragma unroll
                for (int e = 0; e < 4; ++e) { const bool keep = jrow < tc + e, keq = jrow <= tc + e;
                    nab[pt][e] = keep ? nab[pt][e] : 0.f; nak[pt][e] = keep ? nak[pt][e] : 0.f; mbr[pt][e] = keq ? mbr[pt][e] : 0.f; mkr[pt][e] = keq ? mkr[pt][e] : 0.f; }
                rw_store4(NABi, jrow, tc, nab[pt]); rw_store4(NAKi, jrow, tc, nak[pt]); rw_store4(MBRi, jrow, tc, mbr[pt]); rw_store4(MKRi, jrow, tc, mkr[pt]);
                tp[pt] = nab[pt]; ni[pt] = nab[pt];
            }
        }
        __syncthreads();
        RELAUNDER();
        {
            { f32x4 n1[2] = {}; rw_mm<1, 0, 2>(n1, NABi, NABi, p0, q0, fr, fq);
#pragma unroll
              for (int pt = 0; pt < 2; ++pt) { rw_store4(NIb, q0 + fr, p0 + 16 * pt + 4 * fq, n1[pt]); ni[pt] = n1[pt]; } }
            __syncthreads();
#pragma unroll
            for (int it = 1; it <= 4; ++it) {
                const LAS unsigned char* ncur = (it & 1) ? NIb : NIa; LAS unsigned char* nnxt = (it & 1) ? NIa : NIb;
                const LAS unsigned char* tprev = (it == 1) ? NABi : ((it & 1) ? TPb : TPa); LAS unsigned char* tnxt = (it & 1) ? TPa : TPb;
                f32x4 n2[2] = {}, pr[2] = {};
                rw_mm<1, 0, 2>(n2, ncur, ncur, p0, q0, fr, fq);
                rw_mm<1, 0, 2>(pr, ncur, tprev, p0, q0, fr, fq);
#pragma unroll
                for (int pt = 0; pt < 2; ++pt) { tp[pt] = tp[pt] + ni[pt] + pr[pt]; ni[pt] = n2[pt];
                    rw_store4(nnxt, q0 + fr, p0 + 16 * pt + 4 * fq, n2[pt]); rw_store4(tnxt, q0 + fr, p0 + 16 * pt + 4 * fq, tp[pt]); }
                __syncthreads();
            }
            { f32x4 pr[2] = {}; rw_mm<1, 0, 2>(pr, NIb, TPb, p0, q0, fr, fq);
#pragma unroll
              for (int pt = 0; pt < 2; ++pt) { tp[pt] = tp[pt] + ni[pt] + pr[pt];
#pragma unroll
                  for (int e = 0; e < 4; ++e) if (q0 + fr == p0 + 16 * pt + 4 * fq + e) tp[pt][e] += 1.f;
                  rw_store4(TPa, q0 + fr, p0 + 16 * pt + 4 * fq, tp[pt]); } }
            __syncthreads();
        }
        RELAUNDER();
        {
            f32x4 xm[2] = {}, yk[2] = {};
            rw_mm<1, 1, 2>(xm, TPa, ATi, p0, q0, fr, fq);
            rw_mm<1, 0, 2>(yk, TPa, NAKi, p0, q0, fr, fq);
#pragma unroll
            for (int pt = 0; pt < 2; ++pt) { rw_store4(XMi, q0 + fr, p0 + 16 * pt + 4 * fq, xm[pt]); rw_store4(YKi, q0 + fr, p0 + 16 * pt + 4 * fq, yk[pt]); }
        }
        __syncthreads();
        RELAUNDER();
        {
            f32x4 pt_[2] = {};
            rw_mm<0, 1, 2>(pt_, XMi, BHi, p0, q0, fr, fq);
            const int kp = q0 + fr;
            unsigned char* dst = scr + WS_RWPT + (size_t)cid * 8192;
#pragma unroll
            for (int pt = 0; pt < 2; ++pt) {
                const int k = p0 + 16 * pt + 4 * fq;
                f32x4 v = pt_[pt];
#pragma unroll
                for (int e = 0; e < 4; ++e) if (k + e == kp) v[e] += DG[kp];
                const int i = kp >> 5, r32 = kp & 31, tt = k >> 5, s1 = (k >> 4) & 1, jj = (k >> 3) & 1, hh = (k >> 2) & 1;
                u32x2 w; w.x = pk2(v[0], v[1]); w.y = pk2(v[2], v[3]);
                *(u32x2*)(dst + ((i * 4 + 2 * tt + s1) * 64 + r32 + 32 * hh) * 16 + 8 * jj) = w;
            }
        }
        {
            f32x4 z[2] = {};
            rw_mm<1, 0, 2>(z, BHi, YKi, p0, q0, fr, fq);
#pragma unroll
            for (int pt = 0; pt < 2; ++pt) { const int kc = p0 + 16 * pt + 4 * fq; z[pt] = z[pt] + rw_load4(KHi, q0 + fr, kc); rw_store4(ZIi, q0 + fr, kc, z[pt]); }
        }
        {
            f32x4 et[2] = {}, fi[2] = {};
            rw_mm<0, 1, 2>(et, XMi, MBRi, p0, q0, fr, fq);
            rw_mm<1, 0, 2>(fi, MBRi, YKi, p0, q0, fr, fq);
#pragma unroll
            for (int pt = 0; pt < 2; ++pt) { const int c = p0 + 16 * pt + 4 * fq;
                et[pt] = et[pt] + rw_load4(RTi, q0 + fr, c); fi[pt] = fi[pt] + rw_load4(MKRi, q0 + fr, c);
                rw_store4(ETi, q0 + fr, c, et[pt]); rw_store4(FIi, q0 + fr, c, fi[pt]); }
        }
        __syncthreads();
        RELAUNDER();
        {
            f32x4 qc[2] = {};
            rw_mm<1, 1, 2>(qc, ZIi, VTi, p0, q0, fr, fq);
            const int v = q0 + fr, vh = v >> 5, r32v = v & 31;
            unsigned char* dst = scr + WS_RWQT + (size_t)cid * 16384;
#pragma unroll
            for (int pt = 0; pt < 2; ++pt) {
                const int kp = p0 + 16 * pt + 4 * fq;
                const int i = kp >> 5, rr = (kp >> 3) & 3, hh = (kp >> 2) & 1;
                *(f32x4*)(dst + ((((size_t)vh * 2 + i) * 4 + rr) * 64 + r32v + 32 * hh) * 16) = qc[pt];
            }
            *(u32x4*)(A.ws + WS_RWET + (size_t)cid * 8192 + tl * 16) = *(const LAS u32x4*)(ETi + tl * 16);
            *(u32x4*)(A.ws + WS_RWFI + (size_t)cid * 8192 + tl * 16) = *(const LAS u32x4*)(FIi + tl * 16);
            *(u32x4*)(A.ws + WS_RWGG + (size_t)cid * 8192 + tl * 16) = *(const LAS u32x4*)(GGi + tl * 16);
            if (tl < 64) ((float*)(A.ws + WS_RWBON))[(size_t)cid * 64 + tl] = BON[tl];
        }
        __syncthreads();
    }
#undef SLOT
#undef RELAUNDER
}

constexpr int RO_BUF = 40960, RO_XCH = 2 * RO_BUF, RO_BON = RO_XCH + 1024, RO_CONST = RO_BON + 512;
struct RoRaw { u32x4 img[4]; u32x4 vcur, vprv; float bon; };
__device__ __forceinline__ void ro_issue_raw(RoRaw& R, const unsigned char* ws, const unsigned char* scr, const bf16_t* Y, int item, int tid) {
    const int chain = ITEM_CHAIN(item), ci = ITEM_CI(item), b = chain >> 3, h = chain & 7, t0 = ci * 64, cid = chain * 128 + ci;
    R.img[0] = *(const u32x4*)(scr + WS_RWS0 + (size_t)cid * 8192 + tid * 16);
    R.img[1] = *(const u32x4*)(ws + WS_RWET + (size_t)cid * 8192 + tid * 16);
    R.img[2] = *(const u32x4*)(ws + WS_RWFI + (size_t)cid * 8192 + tid * 16);
    R.img[3] = *(const u32x4*)(ws + WS_RWGG + (size_t)cid * 8192 + tid * 16);
    const int t = tid >> 3, jg = tid & 7;
    const bf16_t* yr = Y + ((size_t)b * SEQ + t0 + t) * INC + C_VR + h * 64 + 8 * jg;
    R.vcur = *(const u32x4*)yr; R.vprv = (t0 + t > 0) ? *(const u32x4*)(yr - INC) : (u32x4){0u, 0u, 0u, 0u};
    R.bon = (tid < 64) ? ((const float*)(ws + WS_RWBON))[(size_t)cid * 64 + tid] : 0.f;
}
__device__ __forceinline__ void rwkv_out_phase(LAS unsigned char* lds, const Args& A, const bf16_t* Y, bf16_t* MIX, const unsigned char* scr, int vcu, int G, int tid) {
    const int lane = tid & 63, wid = __builtin_amdgcn_readfirstlane(tid >> 6), fr = lane & 15, fq = lane >> 4;
    const int tb = wid & 3, vhf = wid >> 2;
    LAS float* const XCH = (LAS float*)(lds + RO_XCH);
    LAS float* const BONL = (LAS float*)(lds + RO_BON);
    LAS float* const CH = (LAS float*)(lds + RO_CONST);
    int hcur = -1, cur = 0;
    RoRaw R;
    if (vcu < 4096) ro_issue_raw(R, A.ws, scr, Y, vcu, tid);
    for (int item = vcu; item < 4096; item += G) {
        const int chain = ITEM_CHAIN(item), ci = ITEM_CI(item), b = chain >> 3, h = chain & 7, t0 = ci * 64;
        const size_t row0 = (size_t)b * SEQ + t0;
        if (h != hcur) {
            __syncthreads();
            if (tid < 192) { const int w = tid >> 6, j = tid & 63; CH[tid] = (w == 0) ? A.in[I_MU][(C_VR - C_RW) + h * 64 + j] : (w == 1) ? A.in[I_GNG][h * 64 + j] : A.in[I_GNB][h * 64 + j]; }
            hcur = h;
            __syncthreads();
        }
        LAS unsigned char* buf = lds + cur * RO_BUF;
        LAS unsigned char* S0i = buf; LAS unsigned char* ETi = buf + 8192; LAS unsigned char* FIi = buf + 16384; LAS unsigned char* GGi = buf + 24576; LAS unsigned char* VTi = buf + 32768;
#pragma unroll
        for (int n = 0; n < 4; ++n) *(LAS u32x4*)(buf + n * 8192 + tid * 16) = R.img[n];
        { const int t = tid >> 3, jg = tid & 7; u32x4 o;
#pragma unroll
          for (int e = 0; e < 4; ++e) { const float c0 = BFLO(R.vcur[e]), c1 = BFHI(R.vcur[e]), q0_ = BFLO(R.vprv[e]), q1_ = BFHI(R.vprv[e]);
              o[e] = pk2(c0 + CH[8 * jg + 2 * e] * (q0_ - c0), c1 + CH[8 * jg + 2 * e + 1] * (q1_ - c1)); }
          *(LAS u32x4*)(VTi + rw_off(t, jg)) = o; }
        if (tid < 64) BONL[cur * 64 + tid] = R.bon;
        { const int nitem = item + G; if (nitem < 4096) ro_issue_raw(R, A.ws, scr, Y, nitem, tid); }
        __syncthreads();
        f32x4 o[2] = {};
        rw_mm<0, 0, 2>(o, S0i, ETi, 32 * vhf, 16 * tb, fr, fq);
        rw_mm<1, 1, 2>(o, VTi, FIi, 32 * vhf, 16 * tb, fr, fq);
        const int t = 16 * tb + fr;
        float sm = (o[0][0] + o[0][1]) + (o[0][2] + o[0][3]) + (o[1][0] + o[1][1]) + (o[1][2] + o[1][3]);
        sm += __shfl_xor(sm, 16); sm += __shfl_xor(sm, 32);
        const float mw = sm * (1.f / 32.f); float q = 0.f;
#pragma unroll
        for (int pt = 0; pt < 2; ++pt)
#pragma unroll
            for (int e = 0; e < 4; ++e) { const float d = o[pt][e] - mw; q += d * d; }
        q += __shfl_xor(q, 16); q += __shfl_xor(q, 32);
        if (fq == 0) { XCH[(t * 2 + vhf) * 2] = mw; XCH[(t * 2 + vhf) * 2 + 1] = q; }
        __syncthreads();
        {
            const float mo = XCH[(t * 2 + (vhf ^ 1)) * 2], qo = XCH[(t * 2 + (vhf ^ 1)) * 2 + 1];
            const float mean = 0.5f * (mw + mo), dm = mw - mo, m2 = q + qo + 16.f * dm * dm;
            const float rstd = 1.f / sqrtf(m2 * (1.f / 64.f) + GN_EPS), bon = BONL[cur * 64 + t];
            bf16_t* orow = MIX + (row0 + t) * DM + 512 + h * 64;
#pragma unroll
            for (int pt = 0; pt < 2; ++pt) {
                const int v = 32 * vhf + 16 * pt + 4 * fq;
                const f32x4 gg = *(const LAS f32x4*)(CH + 64 + v), gb = *(const LAS f32x4*)(CH + 128 + v);
                const f32x4 vv = rw_load4(VTi, t, v), gate = rw_load4(GGi, t, v);
                f32x4 res;
#pragma unroll
                for (int e = 0; e < 4; ++e) res[e] = ((o[pt][e] - mean) * rstd * gg[e] + gb[e] + bon * vv[e]) * gate[e];
                u32x2 w; w.x = pk2(res[0], res[1]); w.y = pk2(res[2], res[3]);
                *(u32x2*)(orow + v) = w;
            }
        }
        cur ^= 1;
    }
}

struct ScanRegs { bf16x8 a[2][4]; f32x4 q[2][4]; };
__device__ __forceinline__ void scan_load(ScanRegs& R, const unsigned char* pt, const unsigned char* qt, int c, int lane) {
#pragma unroll
    for (int i = 0; i < 2; ++i)
#pragma unroll
        for (int s = 0; s < 4; ++s) { R.a[i][s] = *(const bf16x8*)(pt + (size_t)c * 8192 + ((i * 4 + s) * 64 + lane) * 16); R.q[i][s] = *(const f32x4*)(qt + (size_t)c * 16384 + ((i * 4 + s) * 64 + lane) * 16); }
}
__device__ __forceinline__ void scan_step(const ScanRegs& R, f32x16& x0, f32x16& x1, unsigned char* s0img, int vrow, int hh) {
    f32x16 n0, n1;
#pragma unroll
    for (int rr = 0; rr < 4; ++rr)
#pragma unroll
        for (int e = 0; e < 4; ++e) { n0[4 * rr + e] = R.q[0][rr][e]; n1[4 * rr + e] = R.q[1][rr][e]; }
    u32x4 bw[4];
#pragma unroll
    for (int s = 0; s < 4; ++s) {
        const f32x16& xs = (s < 2) ? x0 : x1; const int o = 8 * (s & 1);
        bw[s].x = pk2(xs[o + 0], xs[o + 1]); bw[s].y = pk2(xs[o + 2], xs[o + 3]); bw[s].z = pk2(xs[o + 4], xs[o + 5]); bw[s].w = pk2(xs[o + 6], xs[o + 7]);
    }
#pragma unroll
    for (int s = 0; s < 4; ++s) {
        const int tt = s >> 1, g0 = 2 * (s & 1);
        *(u32x2*)(s0img + rw_off(vrow, 4 * tt + g0) + 8 * hh) = (u32x2){bw[s].x, bw[s].y};
        *(u32x2*)(s0img + rw_off(vrow, 4 * tt + g0 + 1) + 8 * hh) = (u32x2){bw[s].z, bw[s].w};
    }
#pragma unroll
    for (int s = 0; s < 4; ++s) {
        const bf16x8 bf = __builtin_bit_cast(bf16x8, bw[s]);
        n0 = __builtin_amdgcn_mfma_f32_32x32x16_bf16(R.a[0][s], bf, n0, 0, 0, 0);
        n1 = __builtin_amdgcn_mfma_f32_32x32x16_bf16(R.a[1][s], bf, n1, 0, 0, 0);
    }
    x0 = n0; x1 = n1;
}
__device__ __forceinline__ void rwkv_scan_phase(unsigned char* scr, int vcu, int tid) {
    if (vcu >= 64 || tid >= 64) return;
    const int lane = tid, chain = vcu >> 1, vh = vcu & 1, r32 = lane & 31, hh = lane >> 5;
    f32x16 x0 = {}, x1 = {};
    const unsigned char* pt = scr + WS_RWPT + (size_t)chain * 128 * 8192;
    const unsigned char* qt = scr + WS_RWQT + (size_t)chain * 128 * 16384 + (size_t)vh * 8192;
    unsigned char* s0 = scr + WS_RWS0 + (size_t)chain * 128 * 8192; const int vrow = 32 * vh + r32;
    ScanRegs RA, RB;
    scan_load(RA, pt, qt, 0, lane);
#pragma unroll 1
    for (int c = 0; c < 128; c += 2) {
        scan_load(RB, pt, qt, c + 1, lane);
        scan_step(RA, x0, x1, s0 + (size_t)c * 8192, vrow, hh);
        scan_load(RA, pt, qt, (c + 2 < 128) ? c + 2 : c, lane);
        scan_step(RB, x0, x1, s0 + (size_t)(c + 1) * 8192, vrow, hh);
    }
}
#define GAS __attribute__((address_space(1)))
typedef GAS unsigned gu32;
typedef GAS unsigned long long gu64;
#define RLX_AGENT __ATOMIC_RELAXED, __HIP_MEMORY_SCOPE_AGENT
#define XB_TMO      128
#define XB_XCNT(j)  (256  + 64 * (j))
#define XB_XSUB(j)  (1280 + 64 * (j))
#define XB_XGEN(j)  (2304 + 64 * (j))
#define XB_TOP      3328
#define XB_TOPGEN   3392
#define XCD_BAR_WORDS 3456
#define XB_SPIN_CAP (1u << 18)

__device__ __forceinline__ unsigned xb_ld(unsigned* p)              { return __hip_atomic_load(p, __ATOMIC_RELAXED, __HIP_MEMORY_SCOPE_AGENT); }
__device__ __forceinline__ unsigned xb_add(unsigned* p, unsigned v) { return __hip_atomic_fetch_add(p, v, __ATOMIC_RELAXED, __HIP_MEMORY_SCOPE_AGENT); }
__device__ __forceinline__ unsigned xb_xcc_id() { return (unsigned)__builtin_amdgcn_s_getreg((3 << 11) | 20) & 0xFu; }
#define XB_SPIN(cond, bar) do { unsigned _sp = 0; while (cond) { __builtin_amdgcn_s_sleep(1); \
    if ((++_sp & 255u) == 0u) { if (xb_ld(&(bar)[XB_TMO])) break; if (_sp > XB_SPIN_CAP) { atomicAdd(&(bar)[XB_TMO], 1u); break; } } } } while (0)

struct XcdBarrier {
    unsigned* bar; unsigned x;
    volatile LAS unsigned* st;
};

__device__ __forceinline__ XcdBarrier xcd_barrier_post(unsigned* bar, volatile LAS unsigned* st) {
    XcdBarrier b; b.bar = bar; b.x = xb_xcc_id(); b.st = st;
    if (threadIdx.x == 0) (void)xb_add(&bar[XB_XCNT(b.x)], 1u);
    return b;
}
__device__ __forceinline__ void xcd_barrier_complete(unsigned* bar, unsigned x, unsigned& nloc, unsigned& nx) {
    const unsigned G = gridDim.x * gridDim.y * gridDim.z;
    unsigned sum, cnt, mine, sp = 0u;
    for (;;) {
        sum = 0u; cnt = 0u; mine = 0u;
#pragma unroll
        for (unsigned j = 0; j < 16; ++j) { const unsigned c = xb_ld(&bar[XB_XCNT(j)]); sum += c; cnt += (c > 0u) ? 1u : 0u; mine = (j == x) ? c : mine; }
        if (sum == G) break;
        __builtin_amdgcn_s_sleep(1);
        if ((++sp & 255u) == 0u) { if (xb_ld(&bar[XB_TMO])) break; if (sp > XB_SPIN_CAP) { atomicAdd(&bar[XB_TMO], 1u); break; } }
    }
    nloc = mine > 0u ? mine : 1u; nx = cnt > 0u ? cnt : 1u;
}

__device__ __forceinline__ void xcd_barrier(const XcdBarrier& b) {
    asm volatile("s_waitcnt vmcnt(0)" ::: "memory");
    __syncthreads();
    if (threadIdx.x == 0) {
        unsigned* bar = b.bar;
        __builtin_amdgcn_s_waitcnt(0);
        unsigned nloc = b.st[0], nx = b.st[1];
        if (nloc == 0u) { xcd_barrier_complete(bar, b.x, nloc, nx); b.st[0] = nloc; b.st[1] = nx; }
        const unsigned old = xb_add(&bar[XB_XSUB(b.x)], 1u);
        const unsigned gen = old / nloc;
        if (old + 1u == (gen + 1u) * nloc) {
            __builtin_amdgcn_fence(__ATOMIC_RELEASE, "agent");
            asm volatile("s_waitcnt vmcnt(0)" ::: "memory");
            const unsigned og = xb_add(&bar[XB_TOP], 1u);
            const unsigned tg = og / nx;
            if (og + 1u == (tg + 1u) * nx) xb_add(&bar[XB_TOPGEN], 1u);
            else XB_SPIN(xb_ld(&bar[XB_TOPGEN]) == tg, bar);
            __builtin_amdgcn_fence(__ATOMIC_ACQUIRE, "agent");
            xb_add(&bar[XB_XGEN(b.x)], 1u);
            asm volatile("s_waitcnt vmcnt(0)" ::: "memory");
        } else {
            XB_SPIN(xb_ld(&bar[XB_XGEN(b.x)]) == gen, bar);
            __builtin_amdgcn_fence(__ATOMIC_ACQUIRE, "agent");
            asm volatile("s_waitcnt vmcnt(0)" ::: "memory");
        }
    }
    __syncthreads();
}

constexpr int N_PHASES = 10;
#ifndef RW_DIRECT
#define RW_DIRECT 0
#endif
constexpr int MISC_OFF = 143360;
constexpr int CW_BAR = 4096;
constexpr size_t CTL_MEMSET_BYTES = 65536;
#ifndef ONE_LAUNCH
#define ONE_LAUNCH 1
#endif
__global__ void __launch_bounds__(NTHREADS, 2) fwd(Args args) {
    extern __shared__ __attribute__((aligned(16))) unsigned char lds_raw[];
    LAS unsigned char* lds = (LAS unsigned char*)lds_raw;
    const int tid = threadIdx.x, G = gridDim.x, bx = blockIdx.x;
    const int vcu = (G % 8 == 0) ? (bx % 8) * (G / 8) + bx / 8 : bx;
    unsigned char* ws = args.ws;
    bf16_t* Y = (bf16_t*)(ws + WS_Y); bf16_t* MIX = (bf16_t*)(ws + WS_MIX);
    const int lo = args.ph_lo, hi = args.ph_hi;
    volatile LAS unsigned* MISC = (volatile LAS unsigned*)(lds + MISC_OFF);
    if (tid < 32) MISC[tid] = 0u;
    __syncthreads();
    XcdBarrier bar; bar.bar = (unsigned*)(ws + WS_CTL) + CW_BAR; bar.x = 0; bar.st = nullptr;
    if (ONE_LAUNCH) bar = xcd_barrier_post((unsigned*)(ws + WS_CTL) + CW_BAR, MISC + 8);
#define GRID_BAR() do { if (ONE_LAUNCH) xcd_barrier(bar); } while (0)
#ifndef PHMASK
#define PHMASK 0xffff
#endif
#define IN(k) (((PHMASK >> (k)) & 1) && lo <= (k) && (k) < hi)
#ifndef PROBE_PH
#define PROBE_PH -1
#endif
#ifndef PROBE_N
#define PROBE_N 1
#endif
#define REP(k) for (int rep_ = 0; rep_ < ((PROBE_PH == (k)) ? PROBE_N : 1); ++rep_)
    if (IN(0)) { REP(0) p0_prologue(args, lds, vcu, G, tid); GRID_BAR(); }
    if (IN(1)) {
        REP(1) {
        pg8::Gemm g{(const bf16_t*)(ws + WS_XB), (const bf16_t*)(ws + WS_WIN), M, INC, DM}; pg8::StaticOrder S; S.init(M, INC, G, bx);
        pg8::EpiInProj E{Y, (const float*)(ws + WS_CS), INC, QSCALE};
        pg8::gemm_phase<pg8::EpiInProj, pg8::StaticOrder, true, true>(lds, g, S, E);
        }
        GRID_BAR();
    }
#if RW_DIRECT
    if (IN(2)) attn_partial_phase(lds, Y, (bf16_t*)(ws + WS_ATTP), (float*)(ws + WS_LSE), vcu, G, tid);
    if (IN(3)) { rwkv_direct_phase(lds, args, Y, MIX, vcu, tid); GRID_BAR(); }
    if (IN(4)) { attn_merge_phase((const bf16_t*)(ws + WS_ATTP), (const float*)(ws + WS_LSE), MIX, vcu, G, tid); GRID_BAR(); }
#else
    if (IN(2)) { REP(20) attn_partial_phase(lds, Y, (bf16_t*)(ws + WS_ATTP), (float*)(ws + WS_LSE), vcu, G, tid);
                 REP(21) rwkv_prep_phase(lds, args, Y, (unsigned char*)args.out, vcu, G, tid); GRID_BAR(); }
    if (IN(3)) { if (vcu < 64) { REP(30) rwkv_scan_phase((unsigned char*)args.out, vcu, tid); }
                 else { REP(31) attn_merge_phase((const bf16_t*)(ws + WS_ATTP), (const float*)(ws + WS_LSE), MIX, vcu - 64, G - 64, tid); }
                 GRID_BAR(); }
    if (IN(4)) { REP(4) rwkv_out_phase(lds, args, Y, MIX, (const unsigned char*)args.out, vcu, G, tid); GRID_BAR(); }
#endif
    if (IN(5)) {
        REP(5) {
        pg8::Gemm g{MIX, (const bf16_t*)(ws + WS_WOUT), M, DM, DM}; pg8::StaticOrder S; S.init(M, DM, G, bx);
        pg8::EpiResF32 E{args.in[I_X], (float*)(ws + WS_TMP5), DM, ALPHA};
        pg8::gemm_phase<pg8::EpiResF32, pg8::StaticOrder, true, true>(lds, g, S, E);
        }
        GRID_BAR();
    }
    if (IN(6)) { REP(6) ln_rows_phase((const float*)(ws + WS_TMP5), args.in[I_LN1G], args.in[I_LN1B], args.out, (bf16_t*)(ws + WS_H1B), vcu, G, tid); GRID_BAR(); }
    if (IN(7)) {
        REP(7) {
        pg8::Gemm g{(const bf16_t*)(ws + WS_H1B), (const bf16_t*)(ws + WS_WGU), M, 2 * FF, DM}; pg8::StaticOrder S; S.init(M, 2 * FF, G, bx);
        pg8::EpiSwiGLU E{(bf16_t*)(ws + WS_HID), FF};
        pg8::gemm_phase<pg8::EpiSwiGLU, pg8::StaticOrder, true, true>(lds, g, S, E);
        }
        GRID_BAR();
    }
    if (IN(8)) {
        REP(8) {
        pg8::Gemm g{(const bf16_t*)(ws + WS_HID), (const bf16_t*)(ws + WS_WDN), M, DM, FF}; pg8::StaticOrder S; S.init(M, DM, G, bx);
        pg8::EpiResF32 E{args.out, (float*)(ws + WS_TMP7), DM, ALPHA};
        pg8::gemm_phase<pg8::EpiResF32, pg8::StaticOrder, true, true>(lds, g, S, E);
        }
        GRID_BAR();
    }
    if (IN(9)) { REP(9) ln_rows_phase((const float*)(ws + WS_TMP7), args.in[I_LN2G], args.in[I_LN2B], args.out, nullptr, vcu, G, tid); }
#if PROBE_PH == 99
    for (int rep_ = 0; rep_ < PROBE_N; ++rep_) GRID_BAR();
#endif
#undef IN
}

extern "C" void kernel_launch(void* const* d_in, const int* in_sizes, int n_in, void* d_out, int out_size, void* d_ws, size_t ws_size, hipStream_t stream) {
    static int grid = 0;
    if (grid == 0) {
        if (n_in != 22 || out_size != M * DM || ws_size < WS_END) { fprintf(stderr, "kernel_launch: unexpected shapes (n_in %d out %d ws %zu)\n", n_in, out_size, ws_size); grid = -1; return; }
        int dev = 0, cus = 0;
        if (hipGetDevice(&dev) != hipSuccess || hipDeviceGetAttribute(&cus, hipDeviceAttributeMultiprocessorCount, dev) != hipSuccess) { grid = -1; return; }
        if (hipFuncSetAttribute((const void*)fwd, hipFuncAttributeMaxDynamicSharedMemorySize, LDS_BYTES) != hipSuccess) { fprintf(stderr, "kernel_launch: hipFuncSetAttribute failed\n"); grid = -1; return; }
        grid = cus;
    }
    if (grid < 0) return;
    Args a{};
    for (int i = 0; i < 22; ++i) a.in[i] = (const float*)d_in[i];
    a.pos = (const int*)d_in[1]; a.out = (float*)d_out; a.ws = (unsigned char*)d_ws;
    if (ONE_LAUNCH) {
        if (hipMemsetAsync((char*)d_ws + WS_CTL, 0, CTL_MEMSET_BYTES, stream) != hipSuccess) { fprintf(stderr, "kernel_launch: memset failed\n"); return; }
        a.ph_lo = 0; a.ph_hi = N_PHASES;
        hipLaunchKernelGGL(fwd, dim3(grid), dim3(NTHREADS), LDS_BYTES, stream, a);
    } else {
        for (int ph = 0; ph < N_PHASES; ++ph) { a.ph_lo = ph; a.ph_hi = ph + 1; hipLaunchKernelGGL(fwd, dim3(grid), dim3(NTHREADS), LDS_BYTES, stream, a); }
    }
}
```

```cpp
#include <hip/hip_runtime.h>
#include <cstdio>
#include <cstdint>
namespace pg8 {
#define PG8_LAS __attribute__((address_space(3)))
typedef unsigned short bf16_t;
typedef short bf16x8 __attribute__((ext_vector_type(8)));
typedef float f32x4 __attribute__((ext_vector_type(4)));
typedef unsigned u32x4 __attribute__((ext_vector_type(4)));
constexpr int BM = 256, BK = 64, HALF = 128, HTB = HALF * BK * 2  , STAGE_BYTES = 8 * HTB, NXCD = 8, WGM = 8;

__host__ __device__ __forceinline__ int lds_byte(int r, int c) { const int st = (r >> 4) * 2 + (c >> 5), rr = r & 15, cc = c & 31, ob = rr * 64 + cc * 2; return st * 1024 + (ob ^ (((ob >> 9) & 1) << 5)); }
__host__ __device__ __forceinline__ void stage_rc(int b, int& R, int& C) { const int st = b / 1024, sb = b % 1024, swz = sb ^ (((sb >> 9) & 1) << 5); R = (st >> 1) * 16 + swz / 64; C = (st & 1) * 32 + (swz % 64) / 2; }
__host__ __device__ __forceinline__ int perm32(int rho) { const int n = rho >> 4, i = rho & 15; return 8 * (i >> 2) + 4 * n + (i & 3); }

struct Unit { int pm, pn; };
struct Gemm { const bf16_t* A; const bf16_t* Bt; int M, N, K; };

struct StaticOrder {
    int nM, nN, nwg, G, c;
    __host__ __device__ void init(int M, int N, int G_, int c_) { nM = M / BM; nN = N / BM; nwg = nM * nN; G = G_; c = c_; }
    __host__ __device__ bool next(int i, Unit& u) const {
        const long L = (long)i * G + c; if (L >= nwg) return false;
        int wgid = (int)L; { const int q = nwg / NXCD, r = nwg % NXCD, xcd = wgid % NXCD, off = wgid / NXCD; wgid = (xcd < r ? xcd * (q + 1) : r * (q + 1) + (xcd - r) * q) + off; }
        const int nig = WGM * nN, gid = wgid / nig, fm = gid * WGM, gsz = (nM - fm) < WGM ? (nM - fm) : WGM;
        u.pm = fm + ((wgid % nig) % gsz); u.pn = (wgid % nig) / gsz; return true;
    }
    __device__ __forceinline__ void a_ready(const Unit&) const {}
    __device__ __forceinline__ void done(const Unit&) const {}
};


__device__ __forceinline__ unsigned cvt_pk_bf16(float lo, float hi) { unsigned r; asm volatile("v_cvt_pk_bf16_f32 %0, %1, %2" : "=v"(r) : "v"(lo), "v"(hi)); return r; }

struct EpiInProj {
    static constexpr bool PERM = true, AFTER_DRAIN = false;
    bf16_t* Y; const float* cs; int ldc; float qscale;
    __device__ __forceinline__ void operator()(const f32x4 (&acc)[2][2][4][2], const Unit& u, int wr, int wc, int fr, int fq) const {
        const int row0 = u.pm * BM + wr * 64 + fr, col0 = u.pn * BM + wc * 32 + 8 * fq;
        const bool rope = (u.pn < 4) && ((wc & 1) == 0);
        const float qs = (u.pn < 2) ? qscale : 1.f;
        const float sg = (fq == 0) ? -1.f : 1.f;
#pragma unroll
        for (int ai = 0; ai < 2; ++ai)
#pragma unroll
            for (int m = 0; m < 4; ++m) {
                const int row = row0 + ai * HALF + m * 16;
                bf16_t* rowp = Y + (size_t)row * ldc + col0;
                f32x4 c0 = {1.f, 1.f, 1.f, 1.f}, c1 = c0, s0 = {0.f, 0.f, 0.f, 0.f}, s1 = s0;
                if (rope) { const f32x4* cp = (const f32x4*)(cs + (size_t)row * 16); c0 = cp[0]; c1 = cp[1]; s0 = cp[2]; s1 = cp[3]; }
#pragma unroll
                for (int bj = 0; bj < 2; ++bj) {
                    f32x4 v0 = acc[ai][bj][m][0], v1 = acc[ai][bj][m][1];
                    if (rope) {
                        f32x4 o0, o1;
#pragma unroll
                        for (int e = 0; e < 4; ++e) { o0[e] = __shfl_xor(v0[e], 16); o1[e] = __shfl_xor(v1[e], 16); }
                        const f32x4 r0 = v0 * c0 + (o0 * s0) * sg, r1 = v1 * c1 + (o1 * s1) * sg;
                        if (fq < 2) { v0 = r0; v1 = r1; }
                    }
                    v0 = v0 * qs; v1 = v1 * qs;
                    u32x4 w; w.x = cvt_pk_bf16(v0[0], v0[1]); w.y = cvt_pk_bf16(v0[2], v0[3]); w.z = cvt_pk_bf16(v1[0], v1[1]); w.w = cvt_pk_bf16(v1[2], v1[3]);
                    *(u32x4*)(rowp + bj * HALF) = w;
                }
            }
    }
};

struct EpiSwiGLU {
    static constexpr bool PERM = true, AFTER_DRAIN = false;
    bf16_t* H; int ldc;
    __device__ __forceinline__ void operator()(const f32x4 (&acc)[2][2][4][2], const Unit& u, int wr, int wc, int fr, int fq) const {
        const int row0 = u.pm * BM + wr * 64 + fr, col0 = u.pn * HALF + wc * 32 + 8 * fq;
#pragma unroll
        for (int ai = 0; ai < 2; ++ai)
#pragma unroll
            for (int m = 0; m < 4; ++m) {
                bf16_t* rowp = H + (size_t)(row0 + ai * HALF + m * 16) * ldc + col0;
                float h[8];
#pragma unroll
                for (int n = 0; n < 2; ++n)
#pragma unroll
                    for (int e = 0; e < 4; ++e) { const float g = acc[ai][0][m][n][e], up = acc[ai][1][m][n][e];
                        const float sig = __builtin_amdgcn_rcpf(1.f + __builtin_amdgcn_exp2f(-1.4426950408889634f * g)); h[n * 4 + e] = g * sig * up; }
                u32x4 w; w.x = cvt_pk_bf16(h[0], h[1]); w.y = cvt_pk_bf16(h[2], h[3]); w.z = cvt_pk_bf16(h[4], h[5]); w.w = cvt_pk_bf16(h[6], h[7]);
                *(u32x4*)rowp = w;
            }
    }
};

struct EpiResF32 {
    static constexpr bool PERM = false, AFTER_DRAIN = false;
    const float* base; float* out; int ldc; float alpha;
    __device__ __forceinline__ void operator()(const f32x4 (&acc)[2][2][4][2], const Unit& u, int wr, int wc, int fr, int fq) const {
        const int row0 = u.pm * BM + wr * 64 + fr, col0 = u.pn * BM + wc * 32 + 4 * fq;
#pragma unroll
        for (int ai = 0; ai < 2; ++ai)
#pragma unroll
            for (int m = 0; m < 4; ++m) { const size_t off = (size_t)(row0 + ai * HALF + m * 16) * ldc + col0;
#pragma unroll
                for (int bj = 0; bj < 2; ++bj)
#pragma unroll
                    for (int n = 0; n < 2; ++n) { const f32x4 bs = *(const f32x4*)(base + off + bj * HALF + n * 16); *(f32x4*)(out + off + bj * HALF + n * 16) = bs * alpha + acc[ai][bj][m][n]; } }
    }
};

template <class Epi, class Sched, bool ALIGN_EPI = false, bool SP2 = false>
__device__ __forceinline__ void gemm_phase(PG8_LAS unsigned char* lds, const Gemm g, const Sched& S, const Epi& E) {
    const int tid = threadIdx.x, wid = __builtin_amdgcn_readfirstlane(tid >> 6), lane = tid & 63, wr = wid >> 2, wc = wid & 3, fr = lane & 15, fq = lane >> 4;
    const int K = g.K, nt = K / BK;
    unsigned voffA[2], voffB[2];
#pragma unroll
    for (int i = 0; i < 2; ++i) { int R, C; stage_rc(tid * 16 + i * 8192, R, C); const int Rb = Epi::PERM ? ((R & ~31) + perm32(R & 31)) : R;
        voffA[i] = (unsigned)(R * K + C) * 2u; voffB[i] = (unsigned)(Rb * K + C) * 2u; }
    const size_t kstep = (size_t)(BK * 2);
    const size_t hstep = (size_t)HALF * K * 2;
    const size_t tstep = 2 * hstep;
    const unsigned ldsw = (unsigned)wid * 1024u;
    const int aoff = lds_byte(wr * 64 + fr, fq * 8), boff = lds_byte(wc * 32 + fr, fq * 8);
#define PG8_SA(b, h) (((b) * 2 + (h)) * HTB)
#define PG8_SB(b, h) ((4 + (b) * 2 + (h)) * HTB)
#define PG8_STAGE(bufoff, gbase, voff) do { _Pragma("unroll") for (int _i = 0; _i < 2; ++_i) \
        __builtin_amdgcn_global_load_lds((const unsigned*)((const char*)(gbase) + (voff)[_i]), (PG8_LAS unsigned*)(lds + (bufoff) + ldsw + _i * 8192), 16, 0, 0); } while (0)
#define PG8_LDA(dst, b, h) do { _Pragma("unroll") for (int m = 0; m < 4; ++m) _Pragma("unroll") for (int k = 0; k < 2; ++k) dst[m][k] = *(const PG8_LAS bf16x8*)(lds + PG8_SA(b, h) + aoff + m * 2048 + k * 1024); } while (0)
#define PG8_LDB(dst, b, h) do { _Pragma("unroll") for (int n = 0; n < 2; ++n) _Pragma("unroll") for (int k = 0; k < 2; ++k) dst[n][k] = *(const PG8_LAS bf16x8*)(lds + PG8_SB(b, h) + boff + n * 2048 + k * 1024); } while (0)
#define PG8_MMA(ai, bj, At, Bt) do { __builtin_amdgcn_s_setprio(1); _Pragma("unroll") for (int m = 0; m < 4; ++m) _Pragma("unroll") for (int n = 0; n < 2; ++n) _Pragma("unroll") for (int k = 0; k < 2; ++k) \
        acc[ai][bj][m][n] = __builtin_amdgcn_mfma_f32_16x16x32_bf16(Bt[n][k], At[m][k], acc[ai][bj][m][n], 0, 0, 0); __builtin_amdgcn_s_setprio(0); } while (0)
#define PG8_WAIT_V(n) asm volatile("s_waitcnt vmcnt(" #n ")" ::: "memory")
#define PG8_WAIT_L(n) asm volatile("s_waitcnt lgkmcnt(" #n ")" ::: "memory")
#define PG8_BAR __builtin_amdgcn_s_barrier()
#define PG8_SCHED __builtin_amdgcn_sched_barrier(0)
    Unit cur, nxt; int ui = 0;
    if (!S.next(0, cur)) return;
    f32x4 acc[2][2][4][2];
#pragma unroll
    for (int a = 0; a < 2; ++a)
#pragma unroll
        for (int b = 0; b < 2; ++b)
#pragma unroll
            for (int m = 0; m < 4; ++m)
#pragma unroll
                for (int n = 0; n < 2; ++n) acc[a][b][m][n] = (f32x4){0.f, 0.f, 0.f, 0.f};
    bf16x8 At[4][2], B0[2][2], B1[2][2];
    const char* cA = (const char*)g.A + (size_t)cur.pm * tstep; const char* cB = (const char*)g.Bt + (size_t)cur.pn * tstep;
    S.a_ready(cur);
    if constexpr (SP2) {
        PG8_STAGE(PG8_SB(0, 0), cB, voffB); PG8_STAGE(PG8_SB(0, 1), cB + hstep, voffB); PG8_STAGE(PG8_SA(0, 0), cA, voffA); PG8_STAGE(PG8_SA(0, 1), cA + hstep, voffA);
        if (wr == 1) PG8_BAR;
        PG8_WAIT_V(2); PG8_BAR;
        PG8_STAGE(PG8_SB(1, 0), cB + kstep, voffB); PG8_STAGE(PG8_SA(1, 0), cA + kstep, voffA); PG8_STAGE(PG8_SB(1, 1), cB + hstep + kstep, voffB);
        PG8_WAIT_V(6); PG8_BAR;
    } else {
        PG8_STAGE(PG8_SB(0, 0), cB, voffB); PG8_STAGE(PG8_SA(0, 0), cA, voffA); PG8_STAGE(PG8_SB(0, 1), cB + hstep, voffB); PG8_STAGE(PG8_SA(0, 1), cA + hstep, voffA);
        if (wr == 1) PG8_BAR;
        PG8_WAIT_V(4); PG8_BAR;
        PG8_STAGE(PG8_SB(1, 0), cB + kstep, voffB); PG8_STAGE(PG8_SA(1, 0), cA + kstep, voffA); PG8_STAGE(PG8_SB(1, 1), cB + hstep + kstep, voffB);
        PG8_WAIT_V(6); PG8_BAR;
    }
    for (;;) {
        const bool has_next = S.next(ui + 1, nxt);
        const char* nA = has_next ? (const char*)g.A + (size_t)nxt.pm * tstep : cA; const char* nB = has_next ? (const char*)g.Bt + (size_t)nxt.pn * tstep : cB;
        for (int t = 0; t < nt; t += 2) {
            const bool last = (t == nt - 2);
            const char* a1 = cA + (size_t)(t + 1) * kstep;
            const char* a2 = last ? nA : cA + (size_t)(t + 2) * kstep; const char* b2 = last ? nB : cB + (size_t)(t + 2) * kstep;
            const char* a3 = a2 + kstep; const char* b3 = b2 + kstep;
            if (last && has_next) S.a_ready(nxt);
            if constexpr (SP2) {
            PG8_LDB(B0, 0, 0); PG8_LDB(B1, 0, 1); PG8_SCHED; PG8_LDA(At, 0, 0); PG8_STAGE(PG8_SA(1, 1), a1 + hstep, voffA);
            PG8_WAIT_V(8); PG8_WAIT_L(0); PG8_BAR; PG8_MMA(0, 0, At, B0); PG8_MMA(0, 1, At, B1); PG8_BAR; PG8_SCHED;
            PG8_LDA(At, 0, 1); PG8_STAGE(PG8_SB(0, 0), b2, voffB); PG8_STAGE(PG8_SB(0, 1), b2 + hstep, voffB); PG8_STAGE(PG8_SA(0, 0), a2, voffA);
            PG8_WAIT_V(8); PG8_WAIT_L(0); PG8_BAR; PG8_MMA(1, 0, At, B0); PG8_MMA(1, 1, At, B1); PG8_BAR; PG8_SCHED;
            PG8_LDB(B0, 1, 0); PG8_LDB(B1, 1, 1); PG8_SCHED; PG8_LDA(At, 1, 0); PG8_STAGE(PG8_SA(0, 1), a2 + hstep, voffA);
            PG8_WAIT_V(8); PG8_WAIT_L(0); PG8_BAR; PG8_MMA(0, 0, At, B0); PG8_MMA(0, 1, At, B1); PG8_BAR; PG8_SCHED;
            PG8_LDA(At, 1, 1); PG8_STAGE(PG8_SB(1, 0), b3, voffB); PG8_STAGE(PG8_SB(1, 1), b3 + hstep, voffB); PG8_STAGE(PG8_SA(1, 0), a3, voffA);
            PG8_WAIT_V(8); PG8_WAIT_L(0); PG8_BAR; PG8_MMA(1, 0, At, B0); PG8_MMA(1, 1, At, B1); PG8_BAR; PG8_SCHED;
            } else {
            PG8_LDB(B0, 0, 0); PG8_SCHED; PG8_LDA(At, 0, 0); PG8_STAGE(PG8_SA(1, 1), a1 + hstep, voffA);
            PG8_WAIT_L(8); PG8_BAR; PG8_WAIT_L(0); PG8_MMA(0, 0, At, B0); PG8_BAR; PG8_SCHED;
            PG8_LDB(B1, 0, 1); PG8_STAGE(PG8_SB(0, 0), b2, voffB);
            PG8_BAR; PG8_WAIT_L(0); PG8_MMA(0, 1, At, B1); PG8_BAR;
            PG8_LDA(At, 0, 1); PG8_STAGE(PG8_SA(0, 0), a2, voffA);
            PG8_BAR; PG8_WAIT_L(0); PG8_MMA(1, 0, At, B0); PG8_BAR; PG8_SCHED;
            PG8_STAGE(PG8_SB(0, 1), b2 + hstep, voffB);
            PG8_WAIT_V(6); PG8_BAR; PG8_MMA(1, 1, At, B1); PG8_BAR;
            PG8_LDB(B0, 1, 0); PG8_SCHED; PG8_LDA(At, 1, 0); PG8_STAGE(PG8_SA(0, 1), a2 + hstep, voffA);
            PG8_WAIT_L(8); PG8_BAR; PG8_WAIT_L(0); PG8_MMA(0, 0, At, B0); PG8_BAR; PG8_SCHED;
            PG8_LDB(B1, 1, 1); PG8_STAGE(PG8_SB(1, 0), b3, voffB);
            PG8_BAR; PG8_WAIT_L(0); PG8_MMA(0, 1, At, B1); PG8_BAR;
            PG8_LDA(At, 1, 1); PG8_STAGE(PG8_SA(1, 0), a3, voffA);
            PG8_BAR; PG8_WAIT_L(0); PG8_MMA(1, 0, At, B0); PG8_BAR; PG8_SCHED;
            PG8_STAGE(PG8_SB(1, 1), b3 + hstep, voffB);
            PG8_WAIT_V(6); PG8_BAR; PG8_MMA(1, 1, At, B1); PG8_BAR;
            }
        }
        if constexpr (ALIGN_EPI) { if (wr == 0) PG8_BAR; }
        if constexpr (!Epi::AFTER_DRAIN) { E(acc, cur, wr, wc, fr, fq); S.done(cur); }
        if (!has_next) break;
#pragma unroll
        for (int a = 0; a < 2; ++a)
#pragma unroll
            for (int b = 0; b < 2; ++b)
#pragma unroll
                for (int m = 0; m < 4; ++m)
#pragma unroll
                    for (int n = 0; n < 2; ++n) acc[a][b][m][n] = (f32x4){0.f, 0.f, 0.f, 0.f};
        cur = nxt; cA = nA; cB = nB; ++ui;
        if constexpr (ALIGN_EPI) { if (wr == 1) PG8_BAR; }
    }
    PG8_WAIT_V(0);
    if constexpr (!ALIGN_EPI) { if (wr == 0) PG8_BAR; }
    PG8_BAR;
    if constexpr (Epi::AFTER_DRAIN) { E.fused(acc, cur, wr, wc, fr, fq, lds, wid, lane); S.done(cur); }
#undef PG8_SA
#undef PG8_SB
#undef PG8_STAGE
#undef PG8_LDA
#undef PG8_LDB
#undef PG8_MMA
#undef PG8_WAIT_V
#undef PG8_WAIT_L
#undef PG8_BAR
#undef PG8_SCHED
}
}

#define LAS __attribute__((address_space(3)))
typedef unsigned short bf16_t;
typedef short bf16x8 __attribute__((ext_vector_type(8)));
typedef short s16x4 __attribute__((ext_vector_type(4)));
typedef float f32x4 __attribute__((ext_vector_type(4)));
typedef float f32x16 __attribute__((ext_vector_type(16)));
typedef unsigned u32x2 __attribute__((ext_vector_type(2)));
typedef unsigned u32x4 __attribute__((ext_vector_type(4)));

constexpr int NB = 4, SEQ = 8192, DM = 1024, M = NB * SEQ, INC = 3328, FF = 2816, NH = 8, HD = 64;
constexpr int C_Q = 0, C_K = 512, C_V = 1024, C_RW = 1536, C_R = 1536, C_KR = 2048, C_VR = 2560, C_DW = 3072, C_DA = 3136, C_DG = 3200;
constexpr float ALPHA = 1.189207115002721f;
constexpr float LN_EPS = 1e-5f, GN_EPS = 64e-5f, L2_EPS = 1e-6f;
constexpr float DECAY_SCALE = 0.6065306597126334f;
constexpr float LOG2E = 1.4426950408889634f;
constexpr float QSCALE = 0.125f * LOG2E;
constexpr int NWAVES = 8, NTHREADS = 512;

constexpr size_t MiB = 1u << 20;
constexpr size_t WS_CTL = 0, CTL_ZERO_BYTES = 1 * MiB;
constexpr size_t WS_WIN = 1 * MiB, WS_WOUT = 8 * MiB, WS_WGU = 10 * MiB, WS_WDN = 21 * MiB, WS_CS = 28 * MiB;
constexpr size_t WS_Y = 32 * MiB;
constexpr size_t WS_HID = 32 * MiB;
constexpr size_t WS_TMP5 = 32 * MiB;
constexpr size_t WS_XB = 240 * MiB;
constexpr size_t WS_ATTP = 240 * MiB;
constexpr size_t WS_TMP7 = 240 * MiB;
constexpr size_t WS_LSE = 336 * MiB;
constexpr size_t WS_MIX = 340 * MiB;
constexpr size_t WS_H1B = 404 * MiB;
constexpr size_t WS_END = 502 * MiB;

constexpr int LDS_BYTES = 147456;

__device__ __forceinline__ unsigned f2bf(float f) { unsigned u = __builtin_bit_cast(unsigned, f); return (u + 0x7fffu + ((u >> 16) & 1u)) >> 16; }
typedef float f32x2_t_ __attribute__((ext_vector_type(2))); typedef __bf16 bf16x2_t_ __attribute__((ext_vector_type(2)));
__device__ __forceinline__ unsigned pk2(float lo, float hi) { f32x2_t_ v = {lo, hi}; bf16x2_t_ b = __builtin_convertvector(v, bf16x2_t_); return __builtin_bit_cast(unsigned, b); }
__device__ __forceinline__ float bf2f(unsigned b) { return __builtin_bit_cast(float, b << 16); }
__device__ __forceinline__ float sigmoidf_(float x) { return __builtin_amdgcn_rcpf(1.f + __builtin_amdgcn_exp2f(-1.4426950408889634f * x)); }
__device__ __forceinline__ float tanhf_(float x) { return 1.f - 2.f * __builtin_amdgcn_rcpf(1.f + __builtin_amdgcn_exp2f(2.8853900817779268f * x)); }
__device__ __forceinline__ float exp_(float x) { return __builtin_amdgcn_exp2f(1.4426950408889634f * x); }
#define LDS_WAIT() asm volatile("s_waitcnt lgkmcnt(0)" ::: "memory")

struct Args {
    const float* in[22]; const int* pos; float* out; unsigned char* ws; int ph_lo, ph_hi, pad0, pad1;
};
enum { I_X = 0, I_POS = 1, I_WIN = 2, I_WOUT = 3, I_MU = 4, I_W0 = 5, I_WD = 6, I_A0 = 7, I_WA = 8, I_WG = 9, I_KK = 10, I_KA = 11, I_RK = 12, I_GNG = 13, I_GNB = 14,
       I_LN1G = 15, I_LN1B = 16, I_FG = 17, I_FU = 18, I_FD = 19, I_LN2G = 20, I_LN2B = 21 };

__device__ __forceinline__ void p0_transpose_item(const float* W, int K, int N, bf16_t* WT, int dst_row0, LAS float* scr, int k0, int n0, int lane) {
#pragma unroll 8
    for (int i = 0; i < 32; ++i) { const int kk = 2 * i + (lane >> 5); scr[kk * 33 + (lane & 31)] = W[(size_t)(k0 + kk) * N + n0 + (lane & 31)]; }
    LDS_WAIT();
    const int c = lane & 7;
#pragma unroll
    for (int j = 0; j < 4; ++j) { const int n = (lane >> 3) + 8 * j; const LAS float* s = scr + (8 * c) * 33 + n;
        u32x4 o; o.x = pk2(s[0 * 33], s[1 * 33]); o.y = pk2(s[2 * 33], s[3 * 33]); o.z = pk2(s[4 * 33], s[5 * 33]); o.w = pk2(s[6 * 33], s[7 * 33]);
        *(u32x4*)(WT + (size_t)(dst_row0 + n) * K + k0 + 8 * c) = o; }
    LDS_WAIT();
}

__device__ __forceinline__ void sincos_rev(float angf, float& c, float& s) {
    const double a = (double)angf;
    double r = a * 0.15915494309189535; r = r - floor(r); if (r >= 0.5) r -= 1.0;
    const double x = r * 6.283185307179586, x2 = x * x;
    double sc = 1.0, ss = 1.0;
    sc = 1.0; ss = 1.0;
#pragma unroll
    for (int k = 13; k >= 1; --k) { sc = 1.0 - sc * x2 * (1.0 / (double)((2 * k - 1) * (2 * k))); ss = 1.0 - ss * x2 * (1.0 / (double)((2 * k) * (2 * k + 1))); }
    c = (float)sc; s = (float)(ss * x);
}

__device__ __forceinline__ void p0_prologue(const Args& A, LAS unsigned char* lds, int vcu, int G, int tid) {
    const int lane = tid & 63, wave = tid >> 6;
    unsigned char* ws = A.ws;
    LAS float* scr = (LAS float*)(lds + wave * 16384);
    const int gw = vcu * NWAVES + wave, NGW = G * NWAVES;
    constexpr int I_IN = (DM / 64) * (INC / 32), I_OUT = (DM / 64) * (DM / 32), I_G = (DM / 64) * (FF / 32), I_D = (FF / 64) * (DM / 32);
    constexpr int NITEMS = I_IN + I_OUT + 2 * I_G + I_D;
    for (int it = gw; it < NITEMS; it += NGW) {
        int r = it;
        if (r < I_IN) { const int nb = INC / 32, kb = r / nb, n0 = 32 * (r % nb); p0_transpose_item(A.in[I_WIN], DM, INC, (bf16_t*)(ws + WS_WIN), n0, scr, 64 * kb, n0, lane); continue; } r -= I_IN;
        if (r < I_OUT) { const int nb = DM / 32, kb = r / nb, n0 = 32 * (r % nb); p0_transpose_item(A.in[I_WOUT], DM, DM, (bf16_t*)(ws + WS_WOUT), n0, scr, 64 * kb, n0, lane); continue; } r -= I_OUT;
        if (r < 2 * I_G) { const int up = r >= I_G; if (up) r -= I_G; const int nb = FF / 32, kb = r / nb, n0 = 32 * (r % nb);
            p0_transpose_item(A.in[up ? I_FU : I_FG], DM, FF, (bf16_t*)(ws + WS_WGU), 256 * (n0 / 128) + (n0 % 128) + (up ? 128 : 0), scr, 64 * kb, n0, lane); continue; } r -= 2 * I_G;
        { const int nb = DM / 32, kb = r / nb, n0 = 32 * (r % nb); p0_transpose_item(A.in[I_FD], FF, DM, (bf16_t*)(ws + WS_WDN), n0, scr, 64 * kb, n0, lane); }
    }
    { const float* x = A.in[I_X]; bf16_t* xb = (bf16_t*)(ws + WS_XB);
      const size_t n8 = (size_t)M * DM / 8;
      for (size_t i = (size_t)vcu * NTHREADS + tid; i < n8; i += (size_t)G * NTHREADS) {
          const f32x4 a = *(const f32x4*)(x + i * 8), b = *(const f32x4*)(x + i * 8 + 4);
          u32x4 o; o.x = pk2(a[0], a[1]); o.y = pk2(a[2], a[3]); o.z = pk2(b[0], b[1]); o.w = pk2(b[2], b[3]);
          *(u32x4*)(xb + i * 8) = o; } }
    for (int idx = vcu * NTHREADS + tid; idx < 8 * 256 * 8; idx += G * NTHREADS) {
        const int h = idx >> 11, i = (idx >> 3) & 255, c = idx & 7;
        const float* src = (i < 64) ? A.in[I_WD] + (size_t)i * 512 : (i < 128) ? A.in[I_WA] + (size_t)(i - 64) * 512 : A.in[I_WG] + (size_t)(i - 128) * 512;
        const f32x4 a = *(const f32x4*)(src + h * 64 + 8 * c), bq = *(const f32x4*)(src + h * 64 + 8 * c + 4);
        u32x4 o; o.x = pk2(a[0], a[1]); o.y = pk2(a[2], a[3]); o.z = pk2(bq[0], bq[1]); o.w = pk2(bq[2], bq[3]);
        const int row = i & 63, sw = (((row >> 1) & 1) << 1) | (((row >> 3) & 1) << 2);
        *(u32x4*)(ws + (27u << 20) + (size_t)h * 32768 + (i >> 6) * 8192 + row * 128 + ((c ^ sw) << 4)) = o;
    }
    { float* cs = (float*)(ws + WS_CS);
      for (int i = vcu * NTHREADS + tid; i < M * 8; i += G * NTHREADS) {
          const int m = i >> 3, f = i & 7;
          const float invf[8] = {1.0f, 0.1939227432012558f, 0.03760603070259094f, 0.007292664609849453f, 0.0014142135623842478f, 0.00027424818836152554f, 5.318296098266728e-05f, 1.0313386155758053e-05f};
          float fr = invf[0];
#pragma unroll
          for (int q = 1; q < 8; ++q) fr = (f == q) ? invf[q] : fr;
          const float ang = (float)A.pos[m] * fr;
          float c, s; sincos_rev(ang, c, s);
          cs[(size_t)m * 16 + f] = c; cs[(size_t)m * 16 + 8 + f] = s; } }
}

__device__ __forceinline__ int crow(int r, int hi) { return (r & 3) + 8 * (r >> 2) + 4 * hi; }
typedef short v4i16_t __attribute__((ext_vector_type(4)));
__device__ __forceinline__ s16x4 vtr(const LAS unsigned char* p) { return __builtin_bit_cast(s16x4, __builtin_amdgcn_ds_read_tr16_b64_v4i16((LAS v4i16_t*)p)); }

constexpr int ATT_KROWS = 384;
constexpr int ATT_LK = 0, ATT_LV = ATT_KROWS * 128, ATT_LW = 2 * ATT_KROWS * 128, ATT_WSCR = 4096 + 256;

__device__ __forceinline__ void attn_partial_phase(LAS unsigned char* lds, const bf16_t* Y, bf16_t* OP, float* LSE, int vcu, int G, int tid) {
    const int lane = tid & 63, wid = __builtin_amdgcn_readfirstlane(tid >> 6), r32 = lane & 31, hi = lane >> 5;
    LAS unsigned char* Kimg = lds + ATT_LK; LAS unsigned char* Vimg = lds + ATT_LV;
    LAS unsigned char* wscr = lds + ATT_LW + wid * ATT_WSCR;
    LAS float* wsf = (LAS float*)(wscr + 4096);
    for (int unit = vcu; unit < 32 * 96; unit += G) {
        const int bh = unit / 96, rem = unit % 96, p = rem >> 5, j = rem & 31;
        const int b = bh >> 3, h = bh & 7;
        const int dl = 2 * p, d = 1 << dl;
        const int nblk = 32 >> dl;
        const int rcls = j / nblk, i0 = (j % nblk) * 256;
        const size_t rowb = (size_t)b * SEQ;
        for (int idx = tid; idx < ATT_KROWS * 8; idx += NTHREADS) {
            const int row = idx >> 3, ch = idx & 7, ci = i0 - 128 + row;
            u32x4 kv = {0u, 0u, 0u, 0u}, vv = kv;
            if (ci >= 0) { const bf16_t* pp = Y + (rowb + (size_t)ci * d + rcls) * INC + h * HD + ch * 8; kv = *(const u32x4*)(pp + C_K); vv = *(const u32x4*)(pp + C_V); }
            *(LAS u32x4*)(Kimg + row * 128 + ((ch ^ ((row >> 1) & 7)) << 4)) = kv;
            *(LAS u32x4*)(Vimg + row * 128 + ((ch ^ (((row >> 1) & 1) << 2)) << 4)) = vv;
        }
        __syncthreads();
        const int qidx = i0 + 32 * wid + r32;
        const bf16_t* qptr = Y + (rowb + (size_t)qidx * d + rcls) * INC + C_Q + h * HD;
        bf16x8 qf[4];
#pragma unroll
        for (int d0 = 0; d0 < 4; ++d0) qf[d0] = *(const bf16x8*)(qptr + 16 * d0 + 8 * hi);
        f32x16 pt[5];
#pragma unroll
        for (int kt = 0; kt < 5; ++kt) {
            f32x16 acc = {};
            const int row = 32 * wid + 32 * kt + r32;
#pragma unroll
            for (int d0 = 0; d0 < 4; ++d0) {
                const int ch = 2 * d0 + hi;
                const bf16x8 kf = *(const LAS bf16x8*)(Kimg + row * 128 + ((ch ^ ((row >> 1) & 7)) << 4));
                acc = __builtin_amdgcn_mfma_f32_32x32x16_bf16(kf, qf[d0], acc, 0, 0, 0);
            }
            pt[kt] = acc;
        }
        float mx = -INFINITY;
#pragma unroll
        for (int kt = 0; kt < 5; ++kt)
#pragma unroll
            for (int r = 0; r < 16; ++r) {
                const int cr = crow(r, hi);
                const int delta = 128 - 32 * kt + r32 - cr;
                const int kidx = i0 - 128 + 32 * wid + 32 * kt + cr;
                const bool valid = (delta >= 0) && (delta <= 128) && (kidx >= 0);
                float v = pt[kt][r]; v = valid ? v : -INFINITY; pt[kt][r] = v; mx = fmaxf(mx, v);
            }
        mx = fmaxf(mx, __shfl_xor(mx, 32));
        float l = 0.f;
#pragma unroll
        for (int kt = 0; kt < 5; ++kt)
#pragma unroll
            for (int r = 0; r < 16; ++r) { const float e = __builtin_amdgcn_exp2f(pt[kt][r] - mx); pt[kt][r] = e; l += e; }
        l += __shfl_xor(l, 32);
        f32x16 o[2]; o[0] = f32x16{}; o[1] = f32x16{};
        const int g1 = (lane >> 4) & 1, q4 = (lane & 15) >> 2, p4 = lane & 3;
#pragma unroll
        for (int kt = 0; kt < 5; ++kt)
#pragma unroll
            for (int s = 0; s < 2; ++s) {
                u32x4 pw;
                pw.x = pk2(pt[kt][8 * s + 0], pt[kt][8 * s + 1]); pw.y = pk2(pt[kt][8 * s + 2], pt[kt][8 * s + 3]);
                pw.z = pk2(pt[kt][8 * s + 4], pt[kt][8 * s + 5]); pw.w = pk2(pt[kt][8 * s + 6], pt[kt][8 * s + 7]);
                const bf16x8 pa = __builtin_bit_cast(bf16x8, pw);
                const int rlo = 32 * wid + 32 * kt + 16 * s + 4 * hi + q4, rhi = rlo + 8;
#pragma unroll
                for (int dh = 0; dh < 2; ++dh) {
                    const int chunk = 4 * dh + 2 * g1 + (p4 >> 1), sub = 8 * (p4 & 1);
                    const s16x4 vlo = vtr(Vimg + rlo * 128 + ((chunk ^ (((rlo >> 1) & 1) << 2)) << 4) + sub);
                    const s16x4 vhi = vtr(Vimg + rhi * 128 + ((chunk ^ (((rhi >> 1) & 1) << 2)) << 4) + sub);
                    const bf16x8 vf = (bf16x8){vlo[0], vlo[1], vlo[2], vlo[3], vhi[0], vhi[1], vhi[2], vhi[3]};
                    o[dh] = __builtin_amdgcn_mfma_f32_32x32x16_bf16(pa, vf, o[dh], 0, 0, 0);
                }
            }
        if (hi == 0) wsf[r32] = l;
        LDS_WAIT();
        bf16_t LAS* stg = (bf16_t LAS*)wscr;
#pragma unroll
        for (int r = 0; r < 16; ++r) {
            const int q = crow(r, hi); const float rl = 1.f / wsf[q];
            stg[q * 64 + r32] = (bf16_t)f2bf(o[0][r] * rl); stg[q * 64 + 32 + r32] = (bf16_t)f2bf(o[1][r] * rl);
        }
        LDS_WAIT();
        bf16_t* OPp = OP + (size_t)p * M * 512;
#pragma unroll
        for (int i = 0; i < 4; ++i) {
            const int q = i * 8 + (lane >> 3), ch = lane & 7;
            const u32x4 v = *(const LAS u32x4*)(wscr + q * 128 + ch * 16);
            const size_t tok = rowb + (size_t)(i0 + 32 * wid + q) * d + rcls;
            *(u32x4*)(OPp + tok * 512 + h * HD + ch * 8) = v;
        }
        if (hi == 0) { const size_t tok = rowb + (size_t)qidx * d + rcls; LSE[(size_t)p * M * 8 + tok * 8 + h] = mx + __log2f(l); }
        __syncthreads();
    }
}

__device__ __forceinline__ void attn_merge_phase(const bf16_t* OP, const float* LSE, bf16_t* MIX, int vcu, int G, int tid) {
    const size_t total = (size_t)M * 64;
    for (size_t i = (size_t)vcu * NTHREADS + tid; i < total; i += (size_t)G * NTHREADS) {
        const size_t tok = i >> 6; const int hc = (int)(i & 63), h = hc >> 3;
        const float l0 = LSE[tok * 8 + h], l1 = LSE[(size_t)M * 8 + tok * 8 + h], l2 = LSE[(size_t)2 * M * 8 + tok * 8 + h];
        const float mx = fmaxf(l0, fmaxf(l1, l2));
        float w0 = __builtin_amdgcn_exp2f(l0 - mx), w1 = __builtin_amdgcn_exp2f(l1 - mx), w2 = __builtin_amdgcn_exp2f(l2 - mx);
        const float inv = 1.f / (w0 + w1 + w2); w0 *= inv; w1 *= inv; w2 *= inv;
        const u32x4 a = *(const u32x4*)(OP + tok * 512 + hc * 8), bq = *(const u32x4*)(OP + (size_t)M * 512 + tok * 512 + hc * 8), c = *(const u32x4*)(OP + (size_t)2 * M * 512 + tok * 512 + hc * 8);
        u32x4 o;
#pragma unroll
        for (int e = 0; e < 4; ++e) {
            const float lo = w0 * bf2f(a[e] & 0xffffu) + w1 * bf2f(bq[e] & 0xffffu) + w2 * bf2f(c[e] & 0xffffu);
            const float hi = w0 * bf2f(a[e] >> 16) + w1 * bf2f(bq[e] >> 16) + w2 * bf2f(c[e] >> 16);
            o[e] = pk2(lo, hi);
        }
        *(u32x4*)(MIX + tok * DM + hc * 8) = o;
    }
}

__device__ __forceinline__ float ysh(const bf16_t* Y, size_t row, int t, int col, const float* mu) {
    const float yc = bf2f(Y[row * INC + col]); const float yp = (t > 0) ? bf2f(Y[(row - 1) * INC + col]) : 0.f;
    return yc + mu[col - C_RW] * (yp - yc);
}
__device__ __forceinline__ void rwkv_direct_phase(LAS unsigned char* lds, const Args& A, const bf16_t* Y, bf16_t* MIX, int vcu, int tid) {
    if (vcu >= 32) return;
    const int b = vcu >> 3, h = vcu & 7;
    LAS float* LIN = (LAS float*)lds;
    LAS float* RR = LIN + 32 * 256;
    LAS float* WW = RR + 2048; LAS float* KM = WW + 2048; LAS float* VV = KM + 2048; LAS float* AV = VV + 2048; LAS float* BV = AV + 2048; LAS float* GG = BV + 2048; LAS float* OB = GG + 2048;
    LAS float* BON = OB + 2048;
    const float* mu = A.in[I_MU];
    float s[8];
#pragma unroll
    for (int i = 0; i < 8; ++i) s[i] = 0.f;
#pragma unroll 1
    for (int ci = 0; ci < SEQ / 32; ++ci) {
        const int t0 = ci * 32; const size_t row0 = (size_t)b * SEQ + t0;
        for (int idx = tid; idx < 32 * 256; idx += NTHREADS) {
            const int tok = idx >> 8, c = idx & 255;
            float v = ysh(Y, row0 + tok, t0 + tok, C_DW + c, mu);
            if (c < 64) v = tanhf(v); else if (c >= 128) v = sigmoidf_(v);
            LIN[idx] = v;
        }
        __syncthreads();
        {
            const int tok = tid >> 4, jg = tid & 15, j0 = 4 * jg, cj = h * 64 + j0;
            float wl[4], al[4], gl[4];
#pragma unroll
            for (int e = 0; e < 4; ++e) { wl[e] = A.in[I_W0][cj + e]; al[e] = A.in[I_A0][cj + e]; gl[e] = 0.f; }
            const LAS float* li = LIN + tok * 256;
#pragma unroll 2
            for (int i = 0; i < 64; ++i) {
                const f32x4 wd = *(const f32x4*)(A.in[I_WD] + (size_t)i * 512 + cj), wa = *(const f32x4*)(A.in[I_WA] + (size_t)i * 512 + cj);
                const float x1 = li[i], x2 = li[64 + i];
#pragma unroll
                for (int e = 0; e < 4; ++e) { wl[e] += x1 * wd[e]; al[e] += x2 * wa[e]; }
            }
#pragma unroll 2
            for (int i = 0; i < 128; ++i) {
                const f32x4 wg = *(const f32x4*)(A.in[I_WG] + (size_t)i * 512 + cj); const float x3 = li[128 + i];
#pragma unroll
                for (int e = 0; e < 4; ++e) gl[e] += x3 * wg[e];
            }
            float r[4], kr[4], vr[4], kk[4]; float n2 = 0.f;
#pragma unroll
            for (int e = 0; e < 4; ++e) {
                r[e] = ysh(Y, row0 + tok, t0 + tok, C_R + cj + e, mu); kr[e] = ysh(Y, row0 + tok, t0 + tok, C_KR + cj + e, mu); vr[e] = ysh(Y, row0 + tok, t0 + tok, C_VR + cj + e, mu);
                kk[e] = kr[e] * A.in[I_KK][cj + e]; n2 += kk[e] * kk[e];
            }
            n2 += __shfl_xor(n2, 1); n2 += __shfl_xor(n2, 2); n2 += __shfl_xor(n2, 4); n2 += __shfl_xor(n2, 8);
            const float inv = 1.f / fmaxf(sqrtf(n2), L2_EPS);
            float bon = 0.f;
#pragma unroll
            for (int e = 0; e < 4; ++e) {
                const float a = sigmoidf_(al[e]); const float dec = __expf(-DECAY_SCALE * sigmoidf_(wl[e]));
                const float kn = kk[e] * inv; const float km = kr[e] * (1.f + (a - 1.f) * A.in[I_KA][cj + e]);
                bon += r[e] * km * A.in[I_RK][cj + e];
                const int o = tok * 64 + j0 + e;
                RR[o] = r[e]; WW[o] = dec; KM[o] = km; VV[o] = vr[e]; AV[o] = -kn; BV[o] = kn * a; GG[o] = gl[e];
            }
            bon += __shfl_xor(bon, 1); bon += __shfl_xor(bon, 2); bon += __shfl_xor(bon, 4); bon += __shfl_xor(bon, 8);
            if (jg == 0) BON[tok] = bon;
        }
        __syncthreads();
        {
            const int v = tid >> 3, kq = tid & 7;
#pragma unroll 1
            for (int t = 0; t < 32; ++t) {
                const int o = t * 64 + 8 * kq;
                const f32x4 a0 = *(const LAS f32x4*)(AV + o), a1 = *(const LAS f32x4*)(AV + o + 4), w0 = *(const LAS f32x4*)(WW + o), w1 = *(const LAS f32x4*)(WW + o + 4);
                const f32x4 b0 = *(const LAS f32x4*)(BV + o), b1 = *(const LAS f32x4*)(BV + o + 4), k0 = *(const LAS f32x4*)(KM + o), k1 = *(const LAS f32x4*)(KM + o + 4);
                const f32x4 r0 = *(const LAS f32x4*)(RR + o), r1 = *(const LAS f32x4*)(RR + o + 4);
                const float vv = VV[t * 64 + v];
                float sa = 0.f;
#pragma unroll
                for (int e = 0; e < 4; ++e) sa += s[e] * a0[e] + s[4 + e] * a1[e];
                sa += __shfl_xor(sa, 1); sa += __shfl_xor(sa, 2); sa += __shfl_xor(sa, 4);
                float oo = 0.f;
#pragma unroll
                for (int e = 0; e < 4; ++e) {
                    s[e] = s[e] * w0[e] + sa * b0[e] + vv * k0[e]; s[4 + e] = s[4 + e] * w1[e] + sa * b1[e] + vv * k1[e];
                    oo += s[e] * r0[e] + s[4 + e] * r1[e];
                }
                oo += __shfl_xor(oo, 1); oo += __shfl_xor(oo, 2); oo += __shfl_xor(oo, 4);
                if (kq == 0) OB[t * 64 + v] = oo;
            }
        }
        __syncthreads();
        {
            const int tok = tid >> 4, jg = tid & 15, v0 = 4 * jg;
            float ov[4], sm = 0.f;
#pragma unroll
            for (int e = 0; e < 4; ++e) { ov[e] = OB[tok * 64 + v0 + e]; sm += ov[e]; }
            sm += __shfl_xor(sm, 1); sm += __shfl_xor(sm, 2); sm += __shfl_xor(sm, 4); sm += __shfl_xor(sm, 8);
            const float mean = sm * (1.f / 64.f); float q = 0.f;
#pragma unroll
            for (int e = 0; e < 4; ++e) { const float dlt = ov[e] - mean; q += dlt * dlt; }
            q += __shfl_xor(q, 1); q += __shfl_xor(q, 2); q += __shfl_xor(q, 4); q += __shfl_xor(q, 8);
            const float rstd = 1.f / sqrtf(q * (1.f / 64.f) + GN_EPS);
            const float bon = BON[tok];
            float res[4];
#pragma unroll
            for (int e = 0; e < 4; ++e) { const int cj = h * 64 + v0 + e;
                const float on = (ov[e] - mean) * rstd * A.in[I_GNG][cj] + A.in[I_GNB][cj];
                res[e] = (on + bon * VV[tok * 64 + v0 + e]) * GG[tok * 64 + v0 + e]; }
            u32x2 w; w.x = pk2(res[0], res[1]); w.y = pk2(res[2], res[3]);
            *(u32x2*)(MIX + (row0 + tok) * DM + 512 + h * 64 + v0) = w;
        }
    }
}

__device__ __forceinline__ float wave_sum(float v) {
#pragma unroll
    for (int o = 1; o < 64; o <<= 1) v += __shfl_xor(v, o);
    return v;
}
__device__ __forceinline__ void ln_rows_phase(const float* in, const float* g, const float* bta, float* outf, bf16_t* outb, int vcu, int G, int tid) {
    const int lane = tid & 63, wave = tid >> 6;
    f32x4 gv[4], bv[4];
#pragma unroll
    for (int j = 0; j < 4; ++j) { gv[j] = *(const f32x4*)(g + 4 * lane + 256 * j); bv[j] = *(const f32x4*)(bta + 4 * lane + 256 * j); }
    for (int m = vcu * NWAVES + wave; m < M; m += G * NWAVES) {
        const f32x4* xr = (const f32x4*)(in + (size_t)m * DM) + lane;
        f32x4 v[4]; float s = 0.f;
#pragma unroll
        for (int j = 0; j < 4; ++j) { v[j] = xr[64 * j]; s += (v[j][0] + v[j][1]) + (v[j][2] + v[j][3]); }
        const float mean = wave_sum(s) * (1.f / DM); float s2 = 0.f;
#pragma unroll
        for (int j = 0; j < 4; ++j) { v[j] = v[j] - mean; s2 += (v[j][0] * v[j][0] + v[j][1] * v[j][1]) + (v[j][2] * v[j][2] + v[j][3] * v[j][3]); }
        const float rstd = 1.f / sqrtf(wave_sum(s2) * (1.f / DM) + LN_EPS);
#pragma unroll
        for (int j = 0; j < 4; ++j) {
            const f32x4 o = v[j] * rstd * gv[j] + bv[j];
            *((f32x4*)(outf + (size_t)m * DM) + lane + 64 * j) = o;
            if (outb) { u32x2 w; w.x = pk2(o[0], o[1]); w.y = pk2(o[2], o[3]); *((u32x2*)(outb + (size_t)m * DM) + lane + 64 * j) = w; }
        }
    }
}


constexpr int RW_SLOT = 8192;
constexpr int RW_SEG = 16 * RW_SLOT, RW_DG = RW_SEG + 2048, RW_BON = RW_DG + 256, RW_CONST = RW_BON + 256;
constexpr size_t WS_LORA = 27 * MiB;
constexpr size_t WS_RWET = 404 * MiB, WS_RWFI = 436 * MiB, WS_RWGG = 468 * MiB, WS_RWBON = 500 * MiB;
constexpr size_t WS_RWPT = 0;
constexpr size_t WS_RWQT = 32 * MiB;
constexpr size_t WS_RWS0 = 96 * MiB;

__device__ __forceinline__ int rw_swz(int row) { return (((row >> 1) & 1) << 1) | (((row >> 3) & 1) << 2); }
__device__ __forceinline__ int rw_off(int row, int chunk) { return row * 128 + ((chunk ^ rw_swz(row)) << 4); }
typedef float f32x2v __attribute__((ext_vector_type(2)));

struct RwLane { int rA0, rA1, cB, cX, sB, sX; };
__device__ __forceinline__ RwLane rw_lane(int fr, int fq) {
    RwLane L; const int p = fr & 3;
    const int sw = rw_swz(fr);
    L.rA0 = fr * 128 + ((fq ^ sw) << 4); L.rA1 = L.rA0 ^ 64;
    const int swc = (((fr >> 3) & 1) << 1) | ((fq & 1) << 2);
    L.cB = (8 * fq + (fr >> 2)) * 128 + 8 * (p & 1); L.cX = ((p >> 1) ^ swc) << 4;
    L.sB = fr * 128 + 8 * (fq & 1); L.sX = ((fq >> 1) ^ sw) << 4;
    return L;
}
template <int COL> __device__ __forceinline__ bf16x8 rw_frag(const LAS unsigned char* img, int u0, int ks, const RwLane& L) {
    if (COL == 0) {
        return *(const LAS bf16x8*)(img + u0 * 128 + (ks ? L.rA1 : L.rA0));
    } else {
        const LAS unsigned char* a = img + ks * 4096 + (L.cB | ((u0 << 1) ^ L.cX));
        const s16x4 lo = vtr(a), hi = vtr(a + 512);
        return (bf16x8){lo[0], lo[1], lo[2], lo[3], hi[0], hi[1], hi[2], hi[3]};
    }
}
template <int FCOL, int SCOL, int NPT> __device__ __forceinline__ void rw_mm(f32x4 (&acc)[NPT], const LAS unsigned char* imgF, const LAS unsigned char* imgS, int p0, int q0, const RwLane& L) {
#pragma unroll
    for (int ks = 0; ks < 2; ++ks) {
        const bf16x8 sf = rw_frag<SCOL>(imgS, q0, ks, L);
#pragma unroll
        for (int pt = 0; pt < NPT; ++pt) { const bf16x8 ff = rw_frag<FCOL>(imgF, p0 + 16 * pt, ks, L); acc[pt] = __builtin_amdgcn_mfma_f32_16x16x32_bf16(ff, sf, acc[pt], 0, 0, 0); }
    }
}
__device__ __forceinline__ void rw_store4(LAS unsigned char* img, int q0, int pc, f32x4 v, const RwLane& L) {
    u32x2 w; w.x = pk2(v[0], v[1]); w.y = pk2(v[2], v[3]);
    *(LAS u32x2*)(img + q0 * 128 + (L.sB | ((pc << 1) ^ L.sX))) = w;
}
__device__ __forceinline__ f32x4 rw_load4(const LAS unsigned char* img, int q0, int pc, const RwLane& L) {
    const u32x2 w = *(const LAS u32x2*)(img + q0 * 128 + (L.sB | ((pc << 1) ^ L.sX)));
    return (f32x4){bf2f(w.x & 0xffffu), bf2f(w.x >> 16), bf2f(w.y & 0xffffu), bf2f(w.y >> 16)};
}

__device__ __forceinline__ void rw_load_consts(LAS float* CH, const Args& A, int h, int tid) {
    const float* mu = A.in[I_MU];
    for (int i = tid; i < 768; i += NTHREADS) {
        float v;
        if (i < 192) v = mu[(i >> 6) * 512 + h * 64 + (i & 63)];
        else if (i < 448) v = mu[(C_DW - C_RW) + (i - 192)];
        else { const int w = (i - 448) >> 6, j = (i - 448) & 63; const float* src = (w == 0) ? A.in[I_KK] : (w == 1) ? A.in[I_KA] : (w == 2) ? A.in[I_RK] : (w == 3) ? A.in[I_W0] : A.in[I_A0]; v = src[h * 64 + j]; }
        CH[i] = v;
    }
}
struct RwRaw { u32x4 lin[4][2]; u32x4 kvr[3][2]; };
__device__ __forceinline__ void rw_issue_lin(RwRaw& R, const bf16_t* Y, size_t row0, int t0, int tid) {
#pragma unroll
    for (int n = 0; n < 4; ++n) {
        const int it = tid + NTHREADS * n, t = it >> 5, c = it & 31;
        const bf16_t* yc = Y + (row0 + t) * INC + C_DW + 8 * c;
        R.lin[n][0] = *(const u32x4*)yc; R.lin[n][1] = (t0 + t > 0) ? *(const u32x4*)(yc - INC) : (u32x4){0u, 0u, 0u, 0u};
    }
}
__device__ __forceinline__ void rw_issue_kvr(RwRaw& R, const bf16_t* Y, size_t row0, int t0, int h, int tid) {
    const int t = tid >> 3, jg = tid & 7;
    const bf16_t* yr = Y + (row0 + t) * INC + h * 64 + 8 * jg;
#pragma unroll
    for (int w = 0; w < 3; ++w) { R.kvr[w][0] = *(const u32x4*)(yr + C_R + 512 * w); R.kvr[w][1] = (t0 + t > 0) ? *(const u32x4*)(yr + C_R + 512 * w - INC) : (u32x4){0u, 0u, 0u, 0u}; }
}
#define BFLO(w) bf2f((w) & 0xffffu)
#define BFHI(w) bf2f((w) >> 16)

__device__ __forceinline__ void rwkv_prep_phase(LAS unsigned char* lds, const Args& A, const bf16_t* Y, unsigned char* scr  , int vcu, int G, int tid) {
    const int lane = tid & 63, wid = __builtin_amdgcn_readfirstlane(tid >> 6);
    int fr = lane & 15, fq = lane >> 4; RwLane L = rw_lane(fr, fq);
    const int wr = wid & 3, wc = wid >> 2, q0 = 16 * wr, p0 = 32 * wc;
#define RELAUNDER() do { asm volatile("" : "+v"(fr), "+v"(fq)); L = rw_lane(fr, fq); } while (0)
#define SLOT(i) (lds + (i) * RW_SLOT)
    LAS unsigned char* const GGi = SLOT(0);
    LAS unsigned char* const ATi = SLOT(1); LAS unsigned char* const BTi = SLOT(2); LAS unsigned char* const KTi = SLOT(3); LAS unsigned char* const RTi = SLOT(4);
    LAS unsigned char* const BHi = SLOT(5); LAS unsigned char* const KHi = SLOT(6); LAS unsigned char* const VTi = SLOT(7);
    LAS unsigned char* const WDi = SLOT(1); LAS unsigned char* const WAi = SLOT(2); LAS unsigned char* const WG0i = SLOT(3); LAS unsigned char* const WG1i = SLOT(4);
    LAS unsigned char* const TDi = SLOT(5); LAS unsigned char* const DAi = SLOT(6); LAS unsigned char* const SG0i = SLOT(7); LAS unsigned char* const SG1i = SLOT(8);
    LAS float* const LW = (LAS float*)SLOT(9);
    LAS float* const AA = (LAS float*)SLOT(11);
    LAS unsigned char* const NABi = SLOT(8); LAS unsigned char* const NAKi = SLOT(9); LAS unsigned char* const MBRi = SLOT(10); LAS unsigned char* const MKRi = SLOT(11);
    LAS unsigned char* const NIa = SLOT(12); LAS unsigned char* const NIb = SLOT(13); LAS unsigned char* const TPa = SLOT(14); LAS unsigned char* const TPb = SLOT(15);
    LAS unsigned char* const XMi = SLOT(2); LAS unsigned char* const YKi = SLOT(3);
    LAS unsigned char* const ZIi = SLOT(12); LAS unsigned char* const ETi = SLOT(13); LAS unsigned char* const FIi = SLOT(15);
    LAS float* const SEG = (LAS float*)(lds + RW_SEG);
    LAS float* const DG = (LAS float*)(lds + RW_DG);
    LAS float* const BON = (LAS float*)(lds + RW_BON);
    LAS float* const CH = (LAS float*)(lds + RW_CONST);
    LAS float* const MUH = CH; LAS float* const KKH = CH + 448; LAS float* const KAH = CH + 512; LAS float* const RKH = CH + 576; LAS float* const W0H = CH + 640; LAS float* const A0H = CH + 704;
    int hcur = -1;
    u32x4 wreg[4];
    RwRaw R;
#define ITEM_CHAIN(it) (((it) >> 3) & 31)
#define ITEM_CI(it) (((it) & 7) + 8 * ((it) >> 8))
    if (vcu < 4096) { const int chain = ITEM_CHAIN(vcu), ci = ITEM_CI(vcu); rw_issue_lin(R, Y, (size_t)(chain >> 3) * SEQ + ci * 64, ci * 64, tid); }
    for (int item = vcu; item < 4096; item += G) {
        const int chain = ITEM_CHAIN(item), ci = ITEM_CI(item);
        const int b = chain >> 3, h = chain & 7, t0 = ci * 64, cid = chain * 128 + ci;
        int tl = tid; asm volatile("" : "+v"(tl));
        const size_t row0 = (size_t)b * SEQ + t0;
        if (h != hcur) {
            __syncthreads();
            rw_load_consts(CH, A, h, tl);
            const unsigned char* lw = A.ws + WS_LORA + (size_t)h * 32768;
#pragma unroll
            for (int n = 0; n < 4; ++n) wreg[n] = *(const u32x4*)(lw + (size_t)(tl + NTHREADS * n) * 16);
            hcur = h;
            __syncthreads();
        }
        rw_issue_kvr(R, Y, row0, t0, h, tl);
#pragma unroll
        for (int n = 0; n < 4; ++n) *(LAS u32x4*)(SLOT(1) + (tl + NTHREADS * n) * 16) = wreg[n];
#pragma unroll
        for (int n = 0; n < 4; ++n) {
            const int it = tl + NTHREADS * n, t = it >> 5, c = it & 31;
            const u32x4 cur = R.lin[n][0], prv = R.lin[n][1];
            float v[8];
#pragma unroll
            for (int e = 0; e < 4; ++e) {
                const float c0 = BFLO(cur[e]), c1 = BFHI(cur[e]), q0_ = BFLO(prv[e]), q1_ = BFHI(prv[e]);
                v[2 * e] = c0 + MUH[192 + 8 * c + 2 * e] * (q0_ - c0); v[2 * e + 1] = c1 + MUH[192 + 8 * c + 2 * e + 1] * (q1_ - c1);
            }
            if (c < 8) {
#pragma unroll
                for (int e = 0; e < 8; ++e) v[e] = tanhf_(v[e]);
            } else if (c >= 16) {
#pragma unroll
                for (int e = 0; e < 8; ++e) v[e] = sigmoidf_(v[e]);
            }
            u32x4 o; o.x = pk2(v[0], v[1]); o.y = pk2(v[2], v[3]); o.z = pk2(v[4], v[5]); o.w = pk2(v[6], v[7]);
            *(LAS u32x4*)(SLOT(5 + (c >> 3)) + rw_off(t, c & 7)) = o;
        }
        __syncthreads();
        RELAUNDER();
        {
            f32x4 aw[2] = {}, aa[2] = {}, ag[2] = {};
            rw_mm<1, 0, 2>(aw, WDi, TDi, p0, q0, L);
            rw_mm<1, 0, 2>(aa, WAi, DAi, p0, q0, L);
            rw_mm<1, 0, 2>(ag, WG0i, SG0i, p0, q0, L);
            rw_mm<1, 0, 2>(ag, WG1i, SG1i, p0, q0, L);
            const int t = q0 + fr;
#pragma unroll
            for (int pt = 0; pt < 2; ++pt) {
                const int j = p0 + 16 * pt + 4 * fq;
                const f32x4 w0v = *(const LAS f32x4*)(W0H + j), a0v = *(const LAS f32x4*)(A0H + j);
                f32x4 lw, av;
#pragma unroll
                for (int e = 0; e < 4; ++e) { lw[e] = -DECAY_SCALE * sigmoidf_(aw[pt][e] + w0v[e]); av[e] = sigmoidf_(aa[pt][e] + a0v[e]); }
                *(LAS f32x4*)(LW + t * 64 + j) = lw; *(LAS f32x4*)(AA + t * 64 + j) = av;
                rw_store4(GGi, q0, p0 + 16 * pt, ag[pt], L);
            }
        }
        __syncthreads();
        {
            const int j = tl & 63, seg = tl >> 6; float acc = 0.f, g[8];
#pragma unroll
            for (int i = 0; i < 8; ++i) { acc += LW[(8 * seg + i) * 64 + j]; g[i] = acc; }
            SEG[seg * 64 + j] = acc;
            __syncthreads();
            float pre = 0.f;
#pragma unroll
            for (int sgi = 0; sgi < 7; ++sgi) pre += (sgi < seg) ? SEG[sgi * 64 + j] : 0.f;
#pragma unroll
            for (int i = 0; i < 8; ++i) LW[(8 * seg + i) * 64 + j] = g[i] + pre;
        }
        __syncthreads();
        {
            int t = tl >> 3, jg = tl & 7; asm volatile("" : "+v"(t), "+v"(jg));
            const int j0 = 8 * jg;
            const u32x4 rcur = R.kvr[0][0], rprv = R.kvr[0][1], kcur = R.kvr[1][0], kprv = R.kvr[1][1], vcur = R.kvr[2][0], vprv = R.kvr[2][1];
            float n2 = 0.f;
#pragma unroll
            for (int e = 0; e < 8; ++e) {
                const unsigned cw = kcur[e >> 1], pw = kprv[e >> 1];
                const float c = (e & 1) ? BFHI(cw) : BFLO(cw), q = (e & 1) ? BFHI(pw) : BFLO(pw);
                const float x = c + MUH[64 + j0 + e] * (q - c);
                const float kk = x * KKH[j0 + e]; n2 += kk * kk;
            }
            n2 += __shfl_xor(n2, 1); n2 += __shfl_xor(n2, 2); n2 += __shfl_xor(n2, 4);
            const float inv = __builtin_amdgcn_rcpf(fmaxf(__builtin_amdgcn_sqrtf(n2), L2_EPS));
            u32x4 pat, pbt, pkt, prt, pbh, pkh, pvt; float bon = 0.f;
#pragma unroll
            for (int e2 = 0; e2 < 4; ++e2) {
                float at[2], bt[2], kt[2], rt[2], bh[2], kh[2], vv[2];
#pragma unroll
                for (int u = 0; u < 2; ++u) {
                    const int e = 2 * e2 + u, j = j0 + e;
                    const float kc = u ? BFHI(kcur[e2]) : BFLO(kcur[e2]), kq = u ? BFHI(kprv[e2]) : BFLO(kprv[e2]);
                    const float rc = u ? BFHI(rcur[e2]) : BFLO(rcur[e2]), rq = u ? BFHI(rprv[e2]) : BFLO(rprv[e2]);
                    const float vc = u ? BFHI(vcur[e2]) : BFLO(vcur[e2]), vq = u ? BFHI(vprv[e2]) : BFLO(vprv[e2]);
                    const float kr = kc + MUH[64 + j] * (kq - kc), r = rc + MUH[j] * (rq - rc), vr = vc + MUH[128 + j] * (vq - vc);
                    const float gt = LW[t * 64 + j], gm1 = t ? LW[(t - 1) * 64 + j] : 0.f, gc = LW[63 * 64 + j];
                    const float a = AA[t * 64 + j];
                    const float kn = kr * KKH[j] * inv, km = kr * (1.f + (a - 1.f) * KAH[j]);
                    const float bvv = kn * a;
                    const float eg = exp_(gt), egm1 = exp_(gm1), eng = exp_(-gt), egc = exp_(gc - gt);
                    at[u] = -kn * egm1; rt[u] = r * eg; bt[u] = bvv * eng; kt[u] = km * eng; bh[u] = bvv * egc; kh[u] = km * egc; vv[u] = vr;
                    bon += r * km * RKH[j];
                    if (t == 63) DG[j] = eg;
                }
                pat[e2] = pk2(at[0], at[1]); pbt[e2] = pk2(bt[0], bt[1]); pkt[e2] = pk2(kt[0], kt[1]); prt[e2] = pk2(rt[0], rt[1]);
                pbh[e2] = pk2(bh[0], bh[1]); pkh[e2] = pk2(kh[0], kh[1]); pvt[e2] = pk2(vv[0], vv[1]);
            }
            bon += __shfl_xor(bon, 1); bon += __shfl_xor(bon, 2); bon += __shfl_xor(bon, 4);
            if (jg == 0) BON[t] = bon;
            const int off = rw_off(t, jg);
            *(LAS u32x4*)(ATi + off) = pat; *(LAS u32x4*)(BTi + off) = pbt; *(LAS u32x4*)(KTi + off) = pkt; *(LAS u32x4*)(RTi + off) = prt;
            *(LAS u32x4*)(BHi + off) = pbh; *(LAS u32x4*)(KHi + off) = pkh; *(LAS u32x4*)(VTi + off) = pvt;
        }
        { const int nitem = item + G; if (nitem < 4096) { const int nchain = ITEM_CHAIN(nitem), nci = ITEM_CI(nitem); rw_issue_lin(R, Y, (size_t)(nchain >> 3) * SEQ + nci * 64, nci * 64, tl); } }
        __syncthreads();
        RELAUNDER();
        f32x4 tp[2], ni[2];
        {
            f32x4 nab[2] = {}, nak[2] = {}, mbr[2] = {}, mkr[2] = {};
            rw_mm<0, 0, 2>(nab, ATi, BTi, p0, q0, L);
            rw_mm<0, 0, 2>(nak, ATi, KTi, p0, q0, L);
            rw_mm<0, 0, 2>(mbr, RTi, BTi, p0, q0, L);
            rw_mm<0, 0, 2>(mkr, RTi, KTi, p0, q0, L);
            const int jrow = q0 + fr;
#pragma unroll
            for (int pt = 0; pt < 2; ++pt) {
                const int tc = p0 + 16 * pt + 4 * fq;
#pragma unroll
                for (int e = 0; e < 4; ++e) { const bool keep = jrow < tc + e, keq = jrow <= tc + e;
                    nab[pt][e] = keep ? nab[pt][e] : 0.f; nak[pt][e] = keep ? nak[pt][e] : 0.f; mbr[pt][e] = keq ? mbr[pt][e] : 0.f; mkr[pt][e] = keq ? mkr[pt][e] : 0.f; }
                rw_store4(NABi, q0, p0 + 16 * pt, nab[pt], L); rw_store4(NAKi, q0, p0 + 16 * pt, nak[pt], L); rw_store4(MBRi, q0, p0 + 16 * pt, mbr[pt], L); rw_store4(MKRi, q0, p0 + 16 * pt, mkr[pt], L);
                tp[pt] = nab[pt]; ni[pt] = nab[pt];
            }
        }
        __syncthreads();
        RELAUNDER();
        {
            { f32x4 n1[2] = {}; rw_mm<1, 0, 2>(n1, NABi, NABi, p0, q0, L);
#pragma unroll
              for (int pt = 0; pt < 2; ++pt) { rw_store4(NIb, q0, p0 + 16 * pt, n1[pt], L); ni[pt] = n1[pt]; } }
            __syncthreads();
#pragma unroll
            for (int it = 1; it <= 4; ++it) {
                const LAS unsigned char* ncur = (it & 1) ? NIb : NIa; LAS unsigned char* nnxt = (it & 1) ? NIa : NIb;
                const LAS unsigned char* tprev = (it == 1) ? NABi : ((it & 1) ? TPb : TPa); LAS unsigned char* tnxt = (it & 1) ? TPa : TPb;
                f32x4 n2[2] = {}, pr[2] = {};
                rw_mm<1, 0, 2>(n2, ncur, ncur, p0, q0, L);
                rw_mm<1, 0, 2>(pr, ncur, tprev, p0, q0, L);
#pragma unroll
                for (int pt = 0; pt < 2; ++pt) { tp[pt] = tp[pt] + ni[pt] + pr[pt]; ni[pt] = n2[pt];
                    rw_store4(nnxt, q0, p0 + 16 * pt, n2[pt], L); rw_store4(tnxt, q0, p0 + 16 * pt, tp[pt], L); }
                __syncthreads();
            }
            { f32x4 pr[2] = {}; rw_mm<1, 0, 2>(pr, NIb, TPb, p0, q0, L);
#pragma unroll
              for (int pt = 0; pt < 2; ++pt) { tp[pt] = tp[pt] + ni[pt] + pr[pt];
#pragma unroll
                  for (int e = 0; e < 4; ++e) if (q0 + fr == p0 + 16 * pt + 4 * fq + e) tp[pt][e] += 1.f;
                  rw_store4(TPa, q0, p0 + 16 * pt, tp[pt], L); } }
            __syncthreads();
        }
        RELAUNDER();
        {
            f32x4 xm[2] = {}, yk[2] = {};
            rw_mm<1, 1, 2>(xm, TPa, ATi, p0, q0, L);
            rw_mm<1, 0, 2>(yk, TPa, NAKi, p0, q0, L);
#pragma unroll
            for (int pt = 0; pt < 2; ++pt) { rw_store4(XMi, q0, p0 + 16 * pt, xm[pt], L); rw_store4(YKi, q0, p0 + 16 * pt, yk[pt], L); }
        }
        __syncthreads();
        RELAUNDER();
        {
            f32x4 pt_[2] = {};
            rw_mm<0, 1, 2>(pt_, XMi, BHi, p0, q0, L);
            const int kp = q0 + fr;
            unsigned char* dst = scr + WS_RWPT + (size_t)cid * 8192;
#pragma unroll
            for (int pt = 0; pt < 2; ++pt) {
                const int k = p0 + 16 * pt + 4 * fq;
                f32x4 v = pt_[pt];
#pragma unroll
                for (int e = 0; e < 4; ++e) if (k + e == kp) v[e] += DG[kp];
                const int i = kp >> 5, r32 = kp & 31, tt = k >> 5, s1 = (k >> 4) & 1, jj = (k >> 3) & 1, hh = (k >> 2) & 1;
                u32x2 w; w.x = pk2(v[0], v[1]); w.y = pk2(v[2], v[3]);
                *(u32x2*)(dst + ((i * 4 + 2 * tt + s1) * 64 + r32 + 32 * hh) * 16 + 8 * jj) = w;
            }
        }
        {
            f32x4 z[2] = {};
            rw_mm<1, 0, 2>(z, BHi, YKi, p0, q0, L);
#pragma unroll
            for (int pt = 0; pt < 2; ++pt) { z[pt] = z[pt] + rw_load4(KHi, q0, p0 + 16 * pt, L); rw_store4(ZIi, q0, p0 + 16 * pt, z[pt], L); }
        }
        {
            f32x4 et[2] = {}, fi[2] = {};
            rw_mm<0, 1, 2>(et, XMi, MBRi, p0, q0, L);
            rw_mm<1, 0, 2>(fi, MBRi, YKi, p0, q0, L);
#pragma unroll
            for (int pt = 0; pt < 2; ++pt) {
                et[pt] = et[pt] + rw_load4(RTi, q0, p0 + 16 * pt, L); fi[pt] = fi[pt] + rw_load4(MKRi, q0, p0 + 16 * pt, L);
                rw_store4(ETi, q0, p0 + 16 * pt, et[pt], L); rw_store4(FIi, q0, p0 + 16 * pt, fi[pt], L); }
        }
        __syncthreads();
        RELAUNDER();
        {
            f32x4 qc[2] = {};
            rw_mm<1, 1, 2>(qc, ZIi, VTi, p0, q0, L);
            const int v = q0 + fr, vh = v >> 5, r32v = v & 31;
            unsigned char* dst = scr + WS_RWQT + (size_t)cid * 16384;
#pragma unroll
            for (int pt = 0; pt < 2; ++pt) {
                const int kp = p0 + 16 * pt + 4 * fq;
                const int i = kp >> 5, rr = (kp >> 3) & 3, hh = (kp >> 2) & 1;
                *(f32x4*)(dst + ((((size_t)vh * 2 + i) * 4 + rr) * 64 + r32v + 32 * hh) * 16) = qc[pt];
            }
            *(u32x4*)(A.ws + WS_RWET + (size_t)cid * 8192 + tl * 16) = *(const LAS u32x4*)(ETi + tl * 16);
            *(u32x4*)(A.ws + WS_RWFI + (size_t)cid * 8192 + tl * 16) = *(const LAS u32x4*)(FIi + tl * 16);
            *(u32x4*)(A.ws + WS_RWGG + (size_t)cid * 8192 + tl * 16) = *(const LAS u32x4*)(GGi + tl * 16);
            if (tl < 64) ((float*)(A.ws + WS_RWBON))[(size_t)cid * 64 + tl] = BON[tl];
        }
        __syncthreads();
    }
#undef SLOT
#undef RELAUNDER
}

constexpr int RO_BUF = 40960, RO_XCH = 2 * RO_BUF, RO_BON = RO_XCH + 1024, RO_CONST = RO_BON + 512;
struct RoRaw { u32x4 img[4]; u32x4 vcur, vprv; float bon; };
__device__ __forceinline__ void ro_issue_raw(RoRaw& R, const unsigned char* ws, const unsigned char* scr, const bf16_t* Y, int item, int tid) {
    const int chain = ITEM_CHAIN(item), ci = ITEM_CI(item), b = chain >> 3, h = chain & 7, t0 = ci * 64, cid = chain * 128 + ci;
    R.img[0] = *(const u32x4*)(scr + WS_RWS0 + (size_t)cid * 8192 + tid * 16);
    R.img[1] = *(const u32x4*)(ws + WS_RWET + (size_t)cid * 8192 + tid * 16);
    R.img[2] = *(const u32x4*)(ws + WS_RWFI + (size_t)cid * 8192 + tid * 16);
    R.img[3] = *(const u32x4*)(ws + WS_RWGG + (size_t)cid * 8192 + tid * 16);
    const int t = tid >> 3, jg = tid & 7;
    const bf16_t* yr = Y + ((size_t)b * SEQ + t0 + t) * INC + C_VR + h * 64 + 8 * jg;
    R.vcur = *(const u32x4*)yr; R.vprv = (t0 + t > 0) ? *(const u32x4*)(yr - INC) : (u32x4){0u, 0u, 0u, 0u};
    R.bon = (tid < 64) ? ((const float*)(ws + WS_RWBON))[(size_t)cid * 64 + tid] : 0.f;
}
__device__ __forceinline__ void rwkv_out_phase(LAS unsigned char* lds, const Args& A, const bf16_t* Y, bf16_t* MIX, const unsigned char* scr, int vcu, int G, int tid) {
    const int lane = tid & 63, wid = __builtin_amdgcn_readfirstlane(tid >> 6), fr = lane & 15, fq = lane >> 4;
    const int tb = wid & 3, vhf = wid >> 2; const RwLane L = rw_lane(fr, fq);
    LAS float* const XCH = (LAS float*)(lds + RO_XCH);
    LAS float* const BONL = (LAS float*)(lds + RO_BON);
    LAS float* const CH = (LAS float*)(lds + RO_CONST);
    int hcur = -1, cur = 0;
    RoRaw R;
    if (vcu < 4096) ro_issue_raw(R, A.ws, scr, Y, vcu, tid);
    for (int item = vcu; item < 4096; item += G) {
        const int chain = ITEM_CHAIN(item), ci = ITEM_CI(item), b = chain >> 3, h = chain & 7, t0 = ci * 64;
        const size_t row0 = (size_t)b * SEQ + t0;
        if (h != hcur) {
            __syncthreads();
            if (tid < 192) { const int w = tid >> 6, j = tid & 63; CH[tid] = (w == 0) ? A.in[I_MU][(C_VR - C_RW) + h * 64 + j] : (w == 1) ? A.in[I_GNG][h * 64 + j] : A.in[I_GNB][h * 64 + j]; }
            hcur = h;
            __syncthreads();
        }
        LAS unsigned char* buf = lds + cur * RO_BUF;
        LAS unsigned char* S0i = buf; LAS unsigned char* ETi = buf + 8192; LAS unsigned char* FIi = buf + 16384; LAS unsigned char* GGi = buf + 24576; LAS unsigned char* VTi = buf + 32768;
#pragma unroll
        for (int n = 0; n < 4; ++n) *(LAS u32x4*)(buf + n * 8192 + tid * 16) = R.img[n];
        { const int t = tid >> 3, jg = tid & 7; u32x4 o;
#pragma unroll
          for (int e = 0; e < 4; ++e) { const float c0 = BFLO(R.vcur[e]), c1 = BFHI(R.vcur[e]), q0_ = BFLO(R.vprv[e]), q1_ = BFHI(R.vprv[e]);
              o[e] = pk2(c0 + CH[8 * jg + 2 * e] * (q0_ - c0), c1 + CH[8 * jg + 2 * e + 1] * (q1_ - c1)); }
          *(LAS u32x4*)(VTi + rw_off(t, jg)) = o; }
        if (tid < 64) BONL[cur * 64 + tid] = R.bon;
        { const int nitem = item + G; if (nitem < 4096) ro_issue_raw(R, A.ws, scr, Y, nitem, tid); }
        __syncthreads();
        f32x4 o[2] = {};
        rw_mm<0, 0, 2>(o, S0i, ETi, 32 * vhf, 16 * tb, L);
        rw_mm<1, 1, 2>(o, VTi, FIi, 32 * vhf, 16 * tb, L);
        const int t = 16 * tb + fr;
        float sm = (o[0][0] + o[0][1]) + (o[0][2] + o[0][3]) + (o[1][0] + o[1][1]) + (o[1][2] + o[1][3]);
        sm += __shfl_xor(sm, 16); sm += __shfl_xor(sm, 32);
        const float mw = sm * (1.f / 32.f); float q = 0.f;
#pragma unroll
        for (int pt = 0; pt < 2; ++pt)
#pragma unroll
            for (int e = 0; e < 4; ++e) { const float d = o[pt][e] - mw; q += d * d; }
        q += __shfl_xor(q, 16); q += __shfl_xor(q, 32);
        if (fq == 0) { XCH[(t * 2 + vhf) * 2] = mw; XCH[(t * 2 + vhf) * 2 + 1] = q; }
        __syncthreads();
        {
            const float mo = XCH[(t * 2 + (vhf ^ 1)) * 2], qo = XCH[(t * 2 + (vhf ^ 1)) * 2 + 1];
            const float mean = 0.5f * (mw + mo), dm = mw - mo, m2 = q + qo + 16.f * dm * dm;
            const float rstd = __builtin_amdgcn_rsqf(m2 * (1.f / 64.f) + GN_EPS), bon = BONL[cur * 64 + t];
            bf16_t* orow = MIX + (row0 + t) * DM + 512 + h * 64;
#pragma unroll
            for (int pt = 0; pt < 2; ++pt) {
                const int v = 32 * vhf + 16 * pt + 4 * fq;
                const f32x4 gg = *(const LAS f32x4*)(CH + 64 + v), gb = *(const LAS f32x4*)(CH + 128 + v);
                const f32x4 vv = rw_load4(VTi, 16 * tb, 32 * vhf + 16 * pt, L), gate = rw_load4(GGi, 16 * tb, 32 * vhf + 16 * pt, L);
                f32x4 res;
#pragma unroll
                for (int e = 0; e < 4; ++e) res[e] = ((o[pt][e] - mean) * rstd * gg[e] + gb[e] + bon * vv[e]) * gate[e];
                u32x2 w; w.x = pk2(res[0], res[1]); w.y = pk2(res[2], res[3]);
                *(u32x2*)(orow + v) = w;
            }
        }
        cur ^= 1;
    }
}

struct ScanRegs { bf16x8 a[2][4]; f32x4 q[2][4]; };
__device__ __forceinline__ void scan_load(ScanRegs& R, const unsigned char* pt, const unsigned char* qt, int c, int lane) {
#pragma unroll
    for (int i = 0; i < 2; ++i)
#pragma unroll
        for (int s = 0; s < 4; ++s) { R.a[i][s] = *(const bf16x8*)(pt + (size_t)c * 8192 + ((i * 4 + s) * 64 + lane) * 16); R.q[i][s] = *(const f32x4*)(qt + (size_t)c * 16384 + ((i * 4 + s) * 64 + lane) * 16); }
}
__device__ __forceinline__ void scan_step(const ScanRegs& R, f32x16& x0, f32x16& x1, unsigned char* s0img, int vrow, int hh) {
    f32x16 n0, n1;
#pragma unroll
    for (int rr = 0; rr < 4; ++rr)
#pragma unroll
        for (int e = 0; e < 4; ++e) { n0[4 * rr + e] = R.q[0][rr][e]; n1[4 * rr + e] = R.q[1][rr][e]; }
    u32x4 bw[4];
#pragma unroll
    for (int s = 0; s < 4; ++s) {
        const f32x16& xs = (s < 2) ? x0 : x1; const int o = 8 * (s & 1);
        bw[s].x = pk2(xs[o + 0], xs[o + 1]); bw[s].y = pk2(xs[o + 2], xs[o + 3]); bw[s].z = pk2(xs[o + 4], xs[o + 5]); bw[s].w = pk2(xs[o + 6], xs[o + 7]);
    }
#pragma unroll
    for (int s = 0; s < 4; ++s) {
        const int tt = s >> 1, g0 = 2 * (s & 1);
        *(u32x2*)(s0img + rw_off(vrow, 4 * tt + g0) + 8 * hh) = (u32x2){bw[s].x, bw[s].y};
        *(u32x2*)(s0img + rw_off(vrow, 4 * tt + g0 + 1) + 8 * hh) = (u32x2){bw[s].z, bw[s].w};
    }
#pragma unroll
    for (int s = 0; s < 4; ++s) {
        const bf16x8 bf = __builtin_bit_cast(bf16x8, bw[s]);
        n0 = __builtin_amdgcn_mfma_f32_32x32x16_bf16(R.a[0][s], bf, n0, 0, 0, 0);
        n1 = __builtin_amdgcn_mfma_f32_32x32x16_bf16(R.a[1][s], bf, n1, 0, 0, 0);
    }
    x0 = n0; x1 = n1;
}
__device__ __forceinline__ void rwkv_scan_phase(unsigned char* scr, int vcu, int tid) {
    if (vcu >= 64 || tid >= 64) return;
    const int lane = tid, chain = vcu >> 1, vh = vcu & 1, r32 = lane & 31, hh = lane >> 5;
    f32x16 x0 = {}, x1 = {};
    const unsigned char* pt = scr + WS_RWPT + (size_t)chain * 128 * 8192;
    const unsigned char* qt = scr + WS_RWQT + (size_t)chain * 128 * 16384 + (size_t)vh * 8192;
    unsigned char* s0 = scr + WS_RWS0 + (size_t)chain * 128 * 8192; const int vrow = 32 * vh + r32;
    ScanRegs RA, RB;
    scan_load(RA, pt, qt, 0, lane);
#pragma unroll 1
    for (int c = 0; c < 128; c += 2) {
        scan_load(RB, pt, qt, c + 1, lane);
        scan_step(RA, x0, x1, s0 + (size_t)c * 8192, vrow, hh);
        scan_load(RA, pt, qt, (c + 2 < 128) ? c + 2 : c, lane);
        scan_step(RB, x0, x1, s0 + (size_t)(c + 1) * 8192, vrow, hh);
    }
}
#define GAS __attribute__((address_space(1)))
typedef GAS unsigned gu32;
typedef GAS unsigned long long gu64;
#define RLX_AGENT __ATOMIC_RELAXED, __HIP_MEMORY_SCOPE_AGENT
#define XB_TMO      128
#define XB_XCNT(j)  (256  + 64 * (j))
#define XB_XSUB(j)  (1280 + 64 * (j))
#define XB_XGEN(j)  (2304 + 64 * (j))
#define XB_TOP      3328
#define XB_TOPGEN   3392
#define XCD_BAR_WORDS 3456
#define XB_SPIN_CAP (1u << 18)

__device__ __forceinline__ unsigned xb_ld(unsigned* p)              { return __hip_atomic_load(p, __ATOMIC_RELAXED, __HIP_MEMORY_SCOPE_AGENT); }
__device__ __forceinline__ unsigned xb_add(unsigned* p, unsigned v) { return __hip_atomic_fetch_add(p, v, __ATOMIC_RELAXED, __HIP_MEMORY_SCOPE_AGENT); }
__device__ __forceinline__ unsigned xb_xcc_id() { return (unsigned)__builtin_amdgcn_s_getreg((3 << 11) | 20) & 0xFu; }
#define XB_SPIN(cond, bar) do { unsigned _sp = 0; while (cond) { __builtin_amdgcn_s_sleep(1); \
    if ((++_sp & 255u) == 0u) { if (xb_ld(&(bar)[XB_TMO])) break; if (_sp > XB_SPIN_CAP) { atomicAdd(&(bar)[XB_TMO], 1u); break; } } } } while (0)

struct XcdBarrier {
    unsigned* bar; unsigned x;
    volatile LAS unsigned* st;
};

__device__ __forceinline__ XcdBarrier xcd_barrier_post(unsigned* bar, volatile LAS unsigned* st) {
    XcdBarrier b; b.bar = bar; b.x = xb_xcc_id(); b.st = st;
    if (threadIdx.x == 0) (void)xb_add(&bar[XB_XCNT(b.x)], 1u);
    return b;
}
__device__ __forceinline__ void xcd_barrier_complete(unsigned* bar, unsigned x, unsigned& nloc, unsigned& nx) {
    const unsigned G = gridDim.x * gridDim.y * gridDim.z;
    unsigned sum, cnt, mine, sp = 0u;
    for (;;) {
        sum = 0u; cnt = 0u; mine = 0u;
#pragma unroll
        for (unsigned j = 0; j < 16; ++j) { const unsigned c = xb_ld(&bar[XB_XCNT(j)]); sum += c; cnt += (c > 0u) ? 1u : 0u; mine = (j == x) ? c : mine; }
        if (sum == G) break;
        __builtin_amdgcn_s_sleep(1);
        if ((++sp & 255u) == 0u) { if (xb_ld(&bar[XB_TMO])) break; if (sp > XB_SPIN_CAP) { atomicAdd(&bar[XB_TMO], 1u); break; } }
    }
    nloc = mine > 0u ? mine : 1u; nx = cnt > 0u ? cnt : 1u;
}

__device__ __forceinline__ void xcd_barrier(const XcdBarrier& b) {
    asm volatile("s_waitcnt vmcnt(0)" ::: "memory");
    __syncthreads();
    if (threadIdx.x == 0) {
        unsigned* bar = b.bar;
        __builtin_amdgcn_s_waitcnt(0);
        unsigned nloc = b.st[0], nx = b.st[1];
        if (nloc == 0u) { xcd_barrier_complete(bar, b.x, nloc, nx); b.st[0] = nloc; b.st[1] = nx; }
        const unsigned old = xb_add(&bar[XB_XSUB(b.x)], 1u);
        const unsigned gen = old / nloc;
        if (old + 1u == (gen + 1u) * nloc) {
            __builtin_amdgcn_fence(__ATOMIC_RELEASE, "agent");
            asm volatile("s_waitcnt vmcnt(0)" ::: "memory");
            const unsigned og = xb_add(&bar[XB_TOP], 1u);
            const unsigned tg = og / nx;
            if (og + 1u == (tg + 1u) * nx) xb_add(&bar[XB_TOPGEN], 1u);
            else XB_SPIN(xb_ld(&bar[XB_TOPGEN]) == tg, bar);
            __builtin_amdgcn_fence(__ATOMIC_ACQUIRE, "agent");
            xb_add(&bar[XB_XGEN(b.x)], 1u);
            asm volatile("s_waitcnt vmcnt(0)" ::: "memory");
        } else {
            XB_SPIN(xb_ld(&bar[XB_XGEN(b.x)]) == gen, bar);
            __builtin_amdgcn_fence(__ATOMIC_ACQUIRE, "agent");
            asm volatile("s_waitcnt vmcnt(0)" ::: "memory");
        }
    }
    __syncthreads();
}

constexpr int N_PHASES = 10;
#ifndef RW_DIRECT
#define RW_DIRECT 0
#endif
constexpr int MISC_OFF = 143360;
constexpr int CW_BAR = 4096;
constexpr size_t CTL_MEMSET_BYTES = 65536;
#ifndef ONE_LAUNCH
#define ONE_LAUNCH 1
#endif
__global__ void __launch_bounds__(NTHREADS, 2) fwd(Args args) {
    extern __shared__ __attribute__((aligned(16))) unsigned char lds_raw[];
    LAS unsigned char* lds = (LAS unsigned char*)lds_raw;
    const int tid = threadIdx.x, G = gridDim.x, bx = blockIdx.x;
    const int vcu = (G % 8 == 0) ? (bx % 8) * (G / 8) + bx / 8 : bx;
    unsigned char* ws = args.ws;
    bf16_t* Y = (bf16_t*)(ws + WS_Y); bf16_t* MIX = (bf16_t*)(ws + WS_MIX);
    const int lo = args.ph_lo, hi = args.ph_hi;
    volatile LAS unsigned* MISC = (volatile LAS unsigned*)(lds + MISC_OFF);
    if (tid < 32) MISC[tid] = 0u;
    __syncthreads();
    XcdBarrier bar; bar.bar = (unsigned*)(ws + WS_CTL) + CW_BAR; bar.x = 0; bar.st = nullptr;
    if (ONE_LAUNCH) bar = xcd_barrier_post((unsigned*)(ws + WS_CTL) + CW_BAR, MISC + 8);
#define GRID_BAR() do { if (ONE_LAUNCH) xcd_barrier(bar); } while (0)
#ifndef PHMASK
#define PHMASK 0xffff
#endif
#define IN(k) (((PHMASK >> (k)) & 1) && lo <= (k) && (k) < hi)
#ifndef PROBE_PH
#define PROBE_PH -1
#endif
#ifndef PROBE_N
#define PROBE_N 1
#endif
#define REP(k) for (int rep_ = 0; rep_ < ((PROBE_PH == (k)) ? PROBE_N : 1); ++rep_)
    if (IN(0)) { REP(0) p0_prologue(args, lds, vcu, G, tid); GRID_BAR(); }
    if (IN(1)) {
        REP(1) {
        pg8::Gemm g{(const bf16_t*)(ws + WS_XB), (const bf16_t*)(ws + WS_WIN), M, INC, DM}; pg8::StaticOrder S; S.init(M, INC, G, bx);
        pg8::EpiInProj E{Y, (const float*)(ws + WS_CS), INC, QSCALE};
        pg8::gemm_phase<pg8::EpiInProj, pg8::StaticOrder, true, true>(lds, g, S, E);
        }
        GRID_BAR();
    }
#if RW_DIRECT
    if (IN(2)) attn_partial_phase(lds, Y, (bf16_t*)(ws + WS_ATTP), (float*)(ws + WS_LSE), vcu, G, tid);
    if (IN(3)) { rwkv_direct_phase(lds, args, Y, MIX, vcu, tid); GRID_BAR(); }
    if (IN(4)) { attn_merge_phase((const bf16_t*)(ws + WS_ATTP), (const float*)(ws + WS_LSE), MIX, vcu, G, tid); GRID_BAR(); }
#else
    if (IN(2)) { REP(20) attn_partial_phase(lds, Y, (bf16_t*)(ws + WS_ATTP), (float*)(ws + WS_LSE), vcu, G, tid);
                 REP(21) rwkv_prep_phase(lds, args, Y, (unsigned char*)args.out, vcu, G, tid); GRID_BAR(); }
    if (IN(3)) { if (vcu < 64) { REP(30) rwkv_scan_phase((unsigned char*)args.out, vcu, tid); }
                 else { REP(31) attn_merge_phase((const bf16_t*)(ws + WS_ATTP), (const float*)(ws + WS_LSE), MIX, vcu - 64, G - 64, tid); }
                 GRID_BAR(); }
    if (IN(4)) { REP(4) rwkv_out_phase(lds, args, Y, MIX, (const unsigned char*)args.out, vcu, G, tid); GRID_BAR(); }
#endif
    if (IN(5)) {
        REP(5) {
        pg8::Gemm g{MIX, (const bf16_t*)(ws + WS_WOUT), M, DM, DM}; pg8::StaticOrder S; S.init(M, DM, G, bx);
        pg8::EpiResF32 E{args.in[I_X], (float*)(ws + WS_TMP5), DM, ALPHA};
        pg8::gemm_phase<pg8::EpiResF32, pg8::StaticOrder, true, true>(lds, g, S, E);
        }
        GRID_BAR();
    }
    if (IN(6)) { REP(6) ln_rows_phase((const float*)(ws + WS_TMP5), args.in[I_LN1G], args.in[I_LN1B], args.out, (bf16_t*)(ws + WS_H1B), vcu, G, tid); GRID_BAR(); }
    if (IN(7)) {
        REP(7) {
        pg8::Gemm g{(const bf16_t*)(ws + WS_H1B), (const bf16_t*)(ws + WS_WGU), M, 2 * FF, DM}; pg8::StaticOrder S; S.init(M, 2 * FF, G, bx);
        pg8::EpiSwiGLU E{(bf16_t*)(ws + WS_HID), FF};
        pg8::gemm_phase<pg8::EpiSwiGLU, pg8::StaticOrder, true, true>(lds, g, S, E);
        }
        GRID_BAR();
    }
    if (IN(8)) {
        REP(8) {
        pg8::Gemm g{(const bf16_t*)(ws + WS_HID), (const bf16_t*)(ws + WS_WDN), M, DM, FF}; pg8::StaticOrder S; S.init(M, DM, G, bx);
        pg8::EpiResF32 E{args.out, (float*)(ws + WS_TMP7), DM, ALPHA};
        pg8::gemm_phase<pg8::EpiResF32, pg8::StaticOrder, true, true>(lds, g, S, E);
        }
        GRID_BAR();
    }
    if (IN(9)) { REP(9) ln_rows_phase((const float*)(ws + WS_TMP7), args.in[I_LN2G], args.in[I_LN2B], args.out, nullptr, vcu, G, tid); }
#if PROBE_PH == 99
    for (int rep_ = 0; rep_ < PROBE_N; ++rep_) GRID_BAR();
#endif
#undef IN
}

extern "C" void kernel_launch(void* const* d_in, const int* in_sizes, int n_in, void* d_out, int out_size, void* d_ws, size_t ws_size, hipStream_t stream) {
    static int grid = 0;
    if (grid == 0) {
        if (n_in != 22 || out_size != M * DM || ws_size < WS_END) { fprintf(stderr, "kernel_launch: unexpected shapes (n_in %d out %d ws %zu)\n", n_in, out_size, ws_size); grid = -1; return; }
        int dev = 0, cus = 0;
        if (hipGetDevice(&dev) != hipSuccess || hipDeviceGetAttribute(&cus, hipDeviceAttributeMultiprocessorCount, dev) != hipSuccess) { grid = -1; return; }
        if (hipFuncSetAttribute((const void*)fwd, hipFuncAttributeMaxDynamicSharedMemorySize, LDS_BYTES) != hipSuccess) { fprintf(stderr, "kernel_launch: hipFuncSetAttribute failed\n"); grid = -1; return; }
        grid = cus;
    }
    if (grid < 0) return;
    Args a{};
    for (int i = 0; i < 22; ++i) a.in[i] = (const float*)d_in[i];
    a.pos = (const int*)d_in[1]; a.out = (float*)d_out; a.ws = (unsigned char*)d_ws;
    if (ONE_LAUNCH) {
        if (hipMemsetAsync((char*)d_ws + WS_CTL, 0, CTL_MEMSET_BYTES, stream) != hipSuccess) { fprintf(stderr, "kernel_launch: memset failed\n"); return; }
        a.ph_lo = 0; a.ph_hi = N_PHASES;
        hipLaunchKernelGGL(fwd, dim3(grid), dim3(NTHREADS), LDS_BYTES, stream, a);
    } else {
        for (int ph = 0; ph < N_PHASES; ++ph) { a.ph_lo = ph; a.ph_hi = ph + 1; hipLaunchKernelGGL(fwd, dim3(grid), dim3(NTHREADS), LDS_BYTES, stream, a); }
    }
}
```
